# Optimizing an MI355X kernel written in HIP

```python
import jax, jax.numpy as jnp
from jax import lax
import numpy as np

D_MODEL = 2048
BATCH = 4
SEQ = 4096
DEPTH = 1

MLSTM_HEADS = 8
MLSTM_QK_DIM = 128
MLSTM_V_DIM = 256
MLSTM_QK_WIDTH = MLSTM_HEADS * MLSTM_QK_DIM
MLSTM_V_WIDTH = MLSTM_HEADS * MLSTM_V_DIM
CHUNK = 64
CONV_WIDTH = D_MODEL
CONV_GROUPS = 16
CONV_K = 3
EPS = 1e-6

SPLIT_WIDTHS = (
    MLSTM_QK_WIDTH, MLSTM_QK_WIDTH,
    MLSTM_V_WIDTH, MLSTM_V_WIDTH, MLSTM_V_WIDTH,
    MLSTM_HEADS, MLSTM_HEADS,
    CONV_WIDTH, CONV_WIDTH, CONV_WIDTH, CONV_WIDTH,
    D_MODEL, D_MODEL,
)
IN_WIDTH = sum(SPLIT_WIDTHS)

kernel_name = "hybrid_mlstm_shortconv_gated_block"


def _split_offsets():
    offs, acc = [], 0
    for w in SPLIT_WIDTHS:
        offs.append(acc)
        acc += w
    return offs


def rms_norm(x, w):
    xf = x.astype(jnp.float32)
    y = xf * lax.rsqrt(jnp.mean(xf * xf, axis=-1, keepdims=True) + EPS)
    return (y * w.astype(jnp.float32)).astype(x.dtype)


def mlstm_chunkwise(q, k, v, i_pre, f_pre):
    f32 = jnp.float32
    bsz, s, h, dk = q.shape
    dv = v.shape[-1]
    nc = s // CHUNK

    def to_chunks(t):
        t = t.astype(f32).reshape((bsz, nc, CHUNK, h) + t.shape[3:])
        return jnp.moveaxis(t, (1, 3), (0, 2))

    qc = to_chunks(q) * (dk ** -0.5)
    kc = to_chunks(k)
    vc = to_chunks(v)
    log_i = to_chunks(i_pre)
    log_f = to_chunks(jax.nn.log_sigmoid(f_pre.astype(f32)))
    causal = jnp.tril(jnp.ones((CHUNK, CHUNK), dtype=bool))

    def step(carry, inp):
        c_state, n_state, m_state = carry
        qb, kb, vb, li, lf = inp
        b = jnp.cumsum(lf, axis=-1)
        g = b[..., -1]
        d_intra = b[..., :, None] - b[..., None, :] + li[..., None, :]
        d_intra = jnp.where(causal, d_intra, -jnp.inf)
        d_inter = b + m_state[..., None]
        m_row = jnp.maximum(d_inter, jnp.max(d_intra, axis=-1))
        w_intra = jnp.exp(d_intra - m_row[..., None])
        w_inter = jnp.exp(d_inter - m_row)
        scores = jnp.einsum('bhld,bhsd->bhls', qb, kb) * w_intra
        num = jnp.einsum('bhls,bhsv->bhlv', scores, vb) \
            + w_inter[..., None] * jnp.einsum('bhld,bhdv->bhlv', qb, c_state)
        den = jnp.sum(scores, axis=-1) + w_inter * jnp.einsum('bhld,bhd->bhl', qb, n_state)
        h_out = num / jnp.maximum(jnp.abs(den), jnp.exp(-m_row))[..., None]
        d_state = g[..., None] - b + li
        m_new = jnp.maximum(g + m_state, jnp.max(d_state, axis=-1))
        ws = jnp.exp(d_state - m_new[..., None])
        keep = jnp.exp(g + m_state - m_new)
        c_new = keep[..., None, None] * c_state + jnp.einsum('bhs,bhsd,bhsv->bhdv', ws, kb, vb)
        n_new = keep[..., None] * n_state + jnp.einsum('bhs,bhsd->bhd', ws, kb)
        return (c_new, n_new, m_new), h_out

    init = (jnp.zeros((bsz, h, dk, dv), f32), jnp.zeros((bsz, h, dk), f32), jnp.zeros((bsz, h), f32))
    _, hs = lax.scan(step, init, (qc, kc, vc, log_i, log_f))
    hs = jnp.moveaxis(hs, (0, 2), (1, 3))
    return hs.reshape(bsz, s, h, dv)


def causal_depthwise_conv(u, w):
    ch = u.shape[-1]
    return lax.conv_general_dilated(
        u, w[:, None, :].astype(u.dtype), window_strides=(1,), padding=[(CONV_K - 1, 0)],
        dimension_numbers=('NWC', 'WIO', 'NWC'), feature_group_count=ch)


def setup_inputs(seed: int = 0) -> dict:
    key = jax.random.key(seed)
    ks = jax.random.split(key, 16)
    d = D_MODEL
    nrm = jax.random.normal
    x = nrm(ks[0], (BATCH, SEQ, d), jnp.float32)
    c = nrm(ks[1], (BATCH, d), jnp.float32)
    norm1_w = 1.0 + 0.05 * nrm(ks[2], (DEPTH, d), jnp.float32)
    w_ada = 0.3 * d ** -0.5 * nrm(ks[3], (DEPTH, d, 3 * d), jnp.float32)
    b_ada = 0.02 * nrm(ks[4], (DEPTH, 3 * d), jnp.float32)
    w_in = d ** -0.5 * nrm(ks[5], (DEPTH, d, IN_WIDTH), jnp.float32)
    b_in = 0.02 * nrm(ks[6], (DEPTH, IN_WIDTH), jnp.float32)
    offs = _split_offsets()
    f_off = offs[6]
    b_in = b_in.at[:, f_off:f_off + MLSTM_HEADS].add(jnp.linspace(3.0, 6.0, MLSTM_HEADS, dtype=jnp.float32))
    conv_w = CONV_K ** -0.5 * nrm(ks[7], (DEPTH, CONV_K, CONV_WIDTH), jnp.float32)
    headnorm_w = 1.0 + 0.05 * nrm(ks[8], (DEPTH, MLSTM_V_WIDTH), jnp.float32)
    w_proj_a = MLSTM_V_WIDTH ** -0.5 * nrm(ks[9], (DEPTH, MLSTM_V_WIDTH, d), jnp.float32)
    w_proj_b = CONV_WIDTH ** -0.5 * nrm(ks[10], (DEPTH, CONV_WIDTH, d), jnp.float32)
    w_out = d ** -0.5 * nrm(ks[11], (DEPTH, d, d), jnp.float32)
    normf_w = 1.0 + 0.05 * nrm(ks[12], (d,), jnp.float32)
    return {"x": x, "c": c, "norm1_w": norm1_w, "w_ada": w_ada, "b_ada": b_ada,
            "w_in": w_in, "b_in": b_in, "conv_w": conv_w, "headnorm_w": headnorm_w,
            "w_proj_a": w_proj_a, "w_proj_b": w_proj_b, "w_out": w_out, "normf_w": normf_w}


def reference(x, c, norm1_w, w_ada, b_ada, w_in, b_in, conv_w, headnorm_w,
              w_proj_a, w_proj_b, w_out, normf_w):
    bsz, s, d = x.shape
    offs = _split_offsets()
    split_points = offs[1:]
    c_act = jax.nn.silu(c)
    for l in range(DEPTH):
        mod = c_act @ w_ada[l] + b_ada[l]
        shift, scale, gate = jnp.split(mod, 3, axis=-1)
        h = rms_norm(x, norm1_w[l]) * (1.0 + scale[:, None, :]) + shift[:, None, :]
        proj = h @ w_in[l] + b_in[l]
        (q, k, v, o, z_a, i_pre, f_pre, u, b_gate, c_gate, z_b, g_a, g_b) = \
            jnp.split(proj, split_points, axis=-1)
        h_a = mlstm_chunkwise(
            q.reshape(bsz, s, MLSTM_HEADS, MLSTM_QK_DIM),
            k.reshape(bsz, s, MLSTM_HEADS, MLSTM_QK_DIM),
            v.reshape(bsz, s, MLSTM_HEADS, MLSTM_V_DIM),
            i_pre, f_pre)
        h_a = jax.nn.sigmoid(o.astype(jnp.float32)).reshape(bsz, s, MLSTM_HEADS, MLSTM_V_DIM) * h_a
        h_a = rms_norm(h_a, headnorm_w[l].reshape(MLSTM_HEADS, MLSTM_V_DIM))
        h_a = h_a.reshape(bsz, s, MLSTM_V_WIDTH).astype(x.dtype) * jax.nn.silu(z_a)
        y_a = h_a @ w_proj_a[l]
        h_b = b_gate * causal_depthwise_conv(c_gate * u, conv_w[l])
        y_b = (h_b * jax.nn.silu(z_b)) @ w_proj_b[l]
        merged = jax.nn.sigmoid(g_a) * y_a + jax.nn.sigmoid(g_b) * y_b
        x = x + gate[:, None, :] * (merged @ w_out[l])
    return rms_norm(x, normf_w)
```

```cpp
#include <hip/hip_runtime.h>
#include <cstdio>
#include <cstdint>

#ifndef MK_N_LAUNCHES
#define MK_N_LAUNCHES 1
#endif

#define LAS __attribute__((address_space(3)))
typedef unsigned short bf16_t;
typedef short bf16x8 __attribute__((ext_vector_type(8)));
typedef short s16x4 __attribute__((ext_vector_type(4)));
typedef float f32x2 __attribute__((ext_vector_type(2)));
typedef float f32x4 __attribute__((ext_vector_type(4)));
typedef float f32x16 __attribute__((ext_vector_type(16)));
typedef unsigned u32x2 __attribute__((ext_vector_type(2)));
typedef unsigned u32x4 __attribute__((ext_vector_type(4)));
#ifndef USE_FP16
#define USE_FP16 0
#endif
#if USE_FP16
typedef _Float16 h2_t __attribute__((ext_vector_type(2)));
typedef _Float16 h8_t __attribute__((ext_vector_type(8)));
#define ONES16 0x3c003c00u
#define MFMA16(a, b, c) __builtin_amdgcn_mfma_f32_16x16x32_f16(__builtin_bit_cast(h8_t, a), __builtin_bit_cast(h8_t, b), c, 0, 0, 0)
#define MFMA32(a, b, c) __builtin_amdgcn_mfma_f32_32x32x16_f16(__builtin_bit_cast(h8_t, a), __builtin_bit_cast(h8_t, b), c, 0, 0, 0)
#else
typedef __bf16 h2_t __attribute__((ext_vector_type(2)));
#define ONES16 0x3f803f80u
#define MFMA16(a, b, c) __builtin_amdgcn_mfma_f32_16x16x32_bf16(a, b, c, 0, 0, 0)
#define MFMA32(a, b, c) __builtin_amdgcn_mfma_f32_32x32x16_bf16(a, b, c, 0, 0, 0)
#endif

constexpr int NB = 4, SEQ = 4096, DM = 2048, MTOK = NB * SEQ;
constexpr int NH = 8, DK = 128, DV = 256, CH = 64, NCH = SEQ / CH;
constexpr int INW = 20496, NPRJ = 20480;
constexpr int O_IF = 8192;
constexpr float EPS = 1e-6f;

__device__ __forceinline__ unsigned pk_bf16(float lo, float hi) { f32x2 v = {lo, hi}; h2_t b = __builtin_convertvector(v, h2_t); return __builtin_bit_cast(unsigned, b); }
#if USE_FP16
__device__ __forceinline__ float bf_lo(unsigned u) { return (float)__builtin_bit_cast(h2_t, u)[0]; }
__device__ __forceinline__ float bf_hi(unsigned u) { return (float)__builtin_bit_cast(h2_t, u)[1]; }
#else
__device__ __forceinline__ float bf_lo(unsigned u) { return __uint_as_float(u << 16); }
__device__ __forceinline__ float bf_hi(unsigned u) { return __uint_as_float(u & 0xffff0000u); }
#endif
__device__ __forceinline__ float sigmoid_f(float x) { return __builtin_amdgcn_rcpf(1.f + __builtin_amdgcn_exp2f(x * -1.4426950408889634f)); }
__device__ __forceinline__ float silu_f(float x) { return x * sigmoid_f(x); }
__device__ __forceinline__ float silu_acc(float x) { return x / (1.f + expf(-x)); }
__device__ __forceinline__ float wave_sum(float v) {
#pragma unroll
    for (int o = 1; o < 64; o <<= 1) v += __shfl_xor(v, o);
    return v;
}

__device__ __forceinline__ int win_src_col(int np) {
    const int pn = np >> 8, jc = np & 255;
    if (pn < 32) return np;
    if (pn < 64) {
        const int c = pn - 32, bj = jc >> 7, wc = (jc >> 5) & 3, fq = (jc >> 3) & 3, n = (jc >> 2) & 1, e = jc & 3;
        return 8208 + 2048 * (2 * bj + n) + 64 * c + 16 * wc + 4 * fq + e;
    }
    return ((jc >> 7) ? 18448 : 16400) + 128 * (pn - 64) + (jc & 127);
}

namespace pg8 {
constexpr int BM = 256, BK = 64, HALF = 128, HTB = HALF * BK * 2, STAGE_BYTES = 8 * HTB, NXCD = 8, WGM = 8;
__host__ __device__ __forceinline__ int lds_byte(int r, int c) { const int st = (r >> 4) * 2 + (c >> 5), rr = r & 15, cc = c & 31, ob = rr * 64 + cc * 2; return st * 1024 + (ob ^ (((ob >> 9) & 1) << 5)); }
__host__ __device__ __forceinline__ void stage_rc(int b, int& R, int& C) { const int st = b / 1024, sb = b % 1024, swz = sb ^ (((sb >> 9) & 1) << 5); R = (st >> 1) * 16 + swz / 64; C = (st & 1) * 32 + (swz % 64) / 2; }
__host__ __device__ __forceinline__ int perm32(int rho) { const int n = rho >> 4, i = rho & 15; return 8 * (i >> 2) + 4 * n + (i & 3); }

__device__ __forceinline__ float ror8(float x) { return __int_as_float(__builtin_amdgcn_update_dpp(0, __float_as_int(x), 0x128, 0xf, 0xf, false)); }
__device__ __forceinline__ f32x4 ror8(f32x4 v) { return (f32x4){ror8(v[0]), ror8(v[1]), ror8(v[2]), ror8(v[3])}; }
__host__ __device__ __forceinline__ size_t ktm(size_t row, int col, int nkt) { return (row >> 8) * ((size_t)nkt * 16384) + (size_t)(col >> 6) * 16384 + (row & 255) * 64 + (size_t)(col & 63); }
struct Unit { int pm, pn, which, par; };
struct Gemm { const bf16_t* A; const bf16_t* Bt; int M, N, K, lda, ldb, koff, bb, ksA, tsA, koffA, ksB, tsB; };

struct StaticOrder {
    int nM, nN, nwg, G, c;
    __device__ void init(int M, int N, int G_, int c_) { nM = M / BM; nN = N / BM; nwg = nM * nN; G = G_; c = c_; }
    __device__ bool next(int i, Unit& u) const {
        const long L = (long)i * G + c; if (L >= nwg) return false;
        int wgid = (int)L; { const int q = nwg / NXCD, r = nwg % NXCD, xcd = wgid % NXCD, off = wgid / NXCD; wgid = (xcd < r ? xcd * (q + 1) : r * (q + 1) + (xcd - r) * q) + off; }
        const int nig = WGM * nN, gid = wgid / nig, fm = gid * WGM, gsz = (nM - fm) < WGM ? (nM - fm) : WGM;
        u.pm = fm + ((wgid % nig) % gsz); u.pn = (wgid % nig) / gsz; u.which = 0; return true;
    }
};

template <class Epi, bool ALIGN_EPI, bool SP2, class Sched = StaticOrder>
__device__ __forceinline__ void gemm_phase(LAS unsigned char* lds, const Gemm g, const Sched& S, const Epi& E) {
    const int tid = threadIdx.x, wid = __builtin_amdgcn_readfirstlane(tid >> 6), lane = tid & 63, wr = wid >> 2, wc = wid & 3, fr = lane & 15, fq = lane >> 4;
    const int K = g.K, nt = K / BK;
    unsigned voffA[2], voffB[2];
#pragma unroll
    for (int i = 0; i < 2; ++i) { int R, C; stage_rc(tid * 16 + i * 8192, R, C); const int Rb = Epi::PERM ? ((R & ~31) + perm32(R & 31)) : R;
        voffA[i] = (unsigned)(R * g.lda + C) * 2u; voffB[i] = (unsigned)(Rb * g.ldb + C) * 2u; }
    const size_t kstep = (size_t)g.ksB;
    const size_t hstepA = (size_t)HALF * g.lda * 2, hstepB = (size_t)HALF * g.ldb * 2;
    const size_t tstepA = (size_t)g.tsA, tstepB = (size_t)g.tsB, kstepA = (size_t)g.ksA;
    const unsigned ldsw = (unsigned)wid * 1024u;
    const int aoff = lds_byte(wr * 64 + fr, fq * 8), boff = lds_byte(wc * 32 + fr, fq * 8);
#define PG8_SA(b, h) (((b) * 2 + (h)) * HTB)
#define PG8_SB(b, h) ((4 + (b) * 2 + (h)) * HTB)
#define PG8_STAGE(bufoff, gbase, voff) do { const char* _gb = (const char*)(gbase); if constexpr (Epi::KHOOK) asm volatile("" : "+s"(_gb)); _Pragma("unroll") for (int _i = 0; _i < 2; ++_i) \
        __builtin_amdgcn_global_load_lds((const unsigned*)(_gb + (voff)[_i]), (LAS unsigned*)(lds + (bufoff) + ldsw + _i * 8192), 16, 0, 0); } while (0)
#define PG8_LDA(dst, b, h) do { _Pragma("unroll") for (int m = 0; m < 4; ++m) _Pragma("unroll") for (int k = 0; k < 2; ++k) dst[m][k] = *(const LAS bf16x8*)(lds + PG8_SA(b, h) + aoff + m * 2048 + k * 1024); } while (0)
#define PG8_LDB(dst, b, h) do { _Pragma("unroll") for (int n = 0; n < 2; ++n) _Pragma("unroll") for (int k = 0; k < 2; ++k) dst[n][k] = *(const LAS bf16x8*)(lds + PG8_SB(b, h) + boff + n * 2048 + k * 1024); } while (0)
#define PG8_MMA(ai, bj, At, Bt) do { __builtin_amdgcn_s_setprio(1); _Pragma("unroll") for (int m = 0; m < 4; ++m) _Pragma("unroll") for (int n = 0; n < 2; ++n) _Pragma("unroll") for (int k = 0; k < 2; ++k) \
        acc[ai][bj][m][n] = MFMA16(Bt[n][k], At[m][k], acc[ai][bj][m][n]); __builtin_amdgcn_s_setprio(0); } while (0)
#define PG8_WAIT_V(n) asm volatile("s_waitcnt vmcnt(" #n ")" ::: "memory")
#define PG8_WAIT_L(n) asm volatile("s_waitcnt lgkmcnt(" #n ")" ::: "memory")
#define PG8_BAR __builtin_amdgcn_s_barrier()
#define PG8_SCHED __builtin_amdgcn_sched_barrier(0)
    Unit cur, nxt; int ui = 0;
    if (!S.next(0, cur)) return;
    cur.par = 0;
    f32x4 acc[2][2][4][2];
#pragma unroll
    for (int a = 0; a < 2; ++a)
#pragma unroll
        for (int b = 0; b < 2; ++b)
#pragma unroll
            for (int m = 0; m < 4; ++m)
#pragma unroll
                for (int n = 0; n < 2; ++n) acc[a][b][m][n] = (f32x4){0.f, 0.f, 0.f, 0.f};
    bf16x8 At[4][2], B0[2][2], B1[2][2];
    const char* cA = (const char*)g.A + (size_t)cur.pm * tstepA + (size_t)cur.which * g.koffA; const char* cB = (const char*)g.Bt + (size_t)cur.pn * tstepB + (size_t)cur.which * g.koff + (size_t)(cur.pm >> 4) * g.bb;
    const float* hkb = nullptr; unsigned hkoffA = 0, hkoffB = 0; f32x4 hx0, hx1;
    if constexpr (Epi::KHOOK) {
        hkb = E.hook_base(cur);
        hkoffA = (unsigned)(((wr * 64 + (fr & 7)) * g.N + wc * 32 + 4 * fq + (fr < 8 ? 0 : 16)) * 4); hkoffB = (unsigned)(((wr * 64 + 8 + (fr & 7)) * g.N + wc * 32 + 4 * fq + (fr < 8 ? 16 : 0)) * 4);
    }
    if constexpr (Epi::LDS_CONST) { if (wid == 0) E.stage_consts(cur, lds, lane); }
    if constexpr (SP2) {
        PG8_STAGE(PG8_SB(0, 0), cB, voffB); PG8_STAGE(PG8_SB(0, 1), cB + hstepB, voffB); PG8_STAGE(PG8_SA(0, 0), cA, voffA); PG8_STAGE(PG8_SA(0, 1), cA + hstepA, voffA);
        if (wr == 1) PG8_BAR;
        PG8_WAIT_V(2); PG8_BAR;
        PG8_STAGE(PG8_SB(1, 0), cB + kstep, voffB); PG8_STAGE(PG8_SA(1, 0), cA + kstepA, voffA); PG8_STAGE(PG8_SB(1, 1), cB + hstepB + kstep, voffB);
        PG8_WAIT_V(6); PG8_BAR;
    } else {
        PG8_STAGE(PG8_SB(0, 0), cB, voffB); PG8_STAGE(PG8_SA(0, 0), cA, voffA); PG8_STAGE(PG8_SB(0, 1), cB + hstepB, voffB); PG8_STAGE(PG8_SA(0, 1), cA + hstepA, voffA);
        if (wr == 1) PG8_BAR;
        PG8_WAIT_V(4); PG8_BAR;
        PG8_STAGE(PG8_SB(1, 0), cB + kstep, voffB); PG8_STAGE(PG8_SA(1, 0), cA + kstepA, voffA); PG8_STAGE(PG8_SB(1, 1), cB + hstepB + kstep, voffB);
        PG8_WAIT_V(6); PG8_BAR;
    }
    for (;;) {
        const bool has_next = S.next(ui + 1, nxt); nxt.par = (ui + 1) & 1;
        const char* nA = has_next ? (const char*)g.A + (size_t)nxt.pm * tstepA + (size_t)nxt.which * g.koffA : cA; const char* nB = has_next ? (const char*)g.Bt + (size_t)nxt.pn * tstepB + (size_t)nxt.which * g.koff + (size_t)(nxt.pm >> 4) * g.bb : cB;
        for (int t0 = 0; t0 < nt; t0 += (Epi::KHOOK ? 8 : 2)) {
#pragma unroll
          for (int hu = 0; hu < (Epi::KHOOK ? 4 : 1); ++hu) {
            const int t = t0 + 2 * hu;
            const bool last = (t == nt - 2);
            const char* a1 = cA + (size_t)(t + 1) * kstepA;
            const char* a2 = last ? nA : cA + (size_t)(t + 2) * kstepA; const char* b2 = last ? nB : cB + (size_t)(t + 2) * kstep;
            const char* a3 = a2 + kstepA; const char* b3 = b2 + kstep;
            if constexpr (SP2) {
            PG8_LDB(B0, 0, 0); PG8_LDB(B1, 0, 1); PG8_SCHED; PG8_LDA(At, 0, 0); PG8_STAGE(PG8_SA(1, 1), a1 + hstepA, voffA);
            if constexpr (Epi::KHOOK) {
                const int hq = t0 >> 3; const float* hp = hkb + (size_t)((hq >> 1) * HALF + hu * 16) * g.N + (hq & 1) * HALF;
                asm volatile("global_load_dwordx4 %0, %1, %2" : "=&v"(hx0) : "v"(hkoffA), "s"(hp) : "memory");
                asm volatile("global_load_dwordx4 %0, %1, %2" : "=&v"(hx1) : "v"(hkoffB), "s"(hp) : "memory");
                PG8_WAIT_V(10);
            } else { PG8_WAIT_V(8); }
            PG8_WAIT_L(0); PG8_BAR; PG8_MMA(0, 0, At, B0); PG8_MMA(0, 1, At, B1); PG8_BAR; PG8_SCHED;
            PG8_LDA(At, 0, 1); PG8_STAGE(PG8_SB(0, 0), b2, voffB); PG8_STAGE(PG8_SB(0, 1), b2 + hstepB, voffB); PG8_STAGE(PG8_SA(0, 0), a2, voffA);
            if constexpr (Epi::KHOOK) { PG8_WAIT_V(10); } else { PG8_WAIT_V(8); }
            PG8_WAIT_L(0); PG8_BAR; PG8_MMA(1, 0, At, B0); PG8_MMA(1, 1, At, B1); PG8_BAR; PG8_SCHED;
            PG8_LDB(B0, 1, 0); PG8_LDB(B1, 1, 1); PG8_SCHED; PG8_LDA(At, 1, 0); PG8_STAGE(PG8_SA(0, 1), a2 + hstepA, voffA);
            PG8_WAIT_V(8); PG8_WAIT_L(0); PG8_BAR; PG8_MMA(0, 0, At, B0); PG8_MMA(0, 1, At, B1); PG8_BAR; PG8_SCHED;
            if constexpr (Epi::KHOOK) {
                const int hq = t0 >> 3;
                const bool lo8 = fr < 8;
                f32x4 own0, oth;
#pragma unroll
                for (int e = 0; e < 4; ++e) { own0[e] = lo8 ? hx0[e] : hx1[e]; oth[e] = lo8 ? hx1[e] : hx0[e]; }
                const f32x4 own1 = ror8(oth);
#pragma unroll
                for (int q = 0; q < 4; ++q) { const float sel = (hq == q) ? 1.f : 0.f;
                    acc[q >> 1][q & 1][hu][0] += own0 * sel; acc[q >> 1][q & 1][hu][1] += own1 * sel; }
                PG8_SCHED;
            }
            PG8_LDA(At, 1, 1); PG8_STAGE(PG8_SB(1, 0), b3, voffB); PG8_STAGE(PG8_SB(1, 1), b3 + hstepB, voffB); PG8_STAGE(PG8_SA(1, 0), a3, voffA);
            PG8_WAIT_V(8); PG8_WAIT_L(0); PG8_BAR; PG8_MMA(1, 0, At, B0); PG8_MMA(1, 1, At, B1); PG8_BAR; PG8_SCHED;
            } else {
            PG8_LDB(B0, 0, 0); PG8_SCHED; PG8_LDA(At, 0, 0); PG8_STAGE(PG8_SA(1, 1), a1 + hstepA, voffA);
            PG8_WAIT_L(8); PG8_BAR; PG8_WAIT_L(0); PG8_MMA(0, 0, At, B0); PG8_BAR; PG8_SCHED;
            PG8_LDB(B1, 0, 1); PG8_STAGE(PG8_SB(0, 0), b2, voffB);
            PG8_BAR; PG8_WAIT_L(0); PG8_MMA(0, 1, At, B1); PG8_BAR;
            PG8_LDA(At, 0, 1); PG8_STAGE(PG8_SA(0, 0), a2, voffA);
            PG8_BAR; PG8_WAIT_L(0); PG8_MMA(1, 0, At, B0); PG8_BAR; PG8_SCHED;
            PG8_STAGE(PG8_SB(0, 1), b2 + hstepB, voffB);
            PG8_WAIT_V(6); PG8_BAR; PG8_MMA(1, 1, At, B1); PG8_BAR;
            PG8_LDB(B0, 1, 0); PG8_SCHED; PG8_LDA(At, 1, 0); PG8_STAGE(PG8_SA(0, 1), a2 + hstepA, voffA);
            PG8_WAIT_L(8); PG8_BAR; PG8_WAIT_L(0); PG8_MMA(0, 0, At, B0); PG8_BAR; PG8_SCHED;
            PG8_LDB(B1, 1, 1); PG8_STAGE(PG8_SB(1, 0), b3, voffB);
            PG8_BAR; PG8_WAIT_L(0); PG8_MMA(0, 1, At, B1); PG8_BAR;
            PG8_LDA(At, 1, 1); PG8_STAGE(PG8_SA(1, 0), a3, voffA);
            PG8_BAR; PG8_WAIT_L(0); PG8_MMA(1, 0, At, B0); PG8_BAR; PG8_SCHED;
            PG8_STAGE(PG8_SB(1, 1), b3 + hstepB, voffB);
            PG8_WAIT_V(6); PG8_BAR; PG8_MMA(1, 1, At, B1); PG8_BAR;
            }
          }
        }
        if constexpr (ALIGN_EPI) { if (wr == 0) PG8_BAR; }
        E(acc, cur, wr, wc, fr, fq);
        if (!has_next) break;
        if (!Epi::keeps_acc(cur)) {
#pragma unroll
        for (int a = 0; a < 2; ++a)
#pragma unroll
            for (int b = 0; b < 2; ++b)
#pragma unroll
                for (int m = 0; m < 4; ++m)
#pragma unroll
                    for (int n = 0; n < 2; ++n) acc[a][b][m][n] = (f32x4){0.f, 0.f, 0.f, 0.f};
        }
        cur = nxt; cA = nA; cB = nB; ++ui;
        if constexpr (Epi::KHOOK) hkb = E.hook_base(cur);
        if constexpr (Epi::LDS_CONST) { if (wid == 0) E.stage_consts(cur, lds, lane); }
        if constexpr (ALIGN_EPI) { if (wr == 1) PG8_BAR; }
    }
    PG8_WAIT_V(0);
    if constexpr (!ALIGN_EPI) { if (wr == 0) PG8_BAR; }
    PG8_BAR;
#undef PG8_SA
#undef PG8_SB
#undef PG8_STAGE
#undef PG8_LDA
#undef PG8_LDB
#undef PG8_MMA
#undef PG8_WAIT_V
#undef PG8_WAIT_L
#undef PG8_BAR
#undef PG8_SCHED
}


struct EpiInProj {
    static __device__ __forceinline__ bool keeps_acc(const Unit&) { return false; }
    static constexpr bool PERM = true; static constexpr bool LDS_CONST = true; static constexpr bool KHOOK = false;
    bf16_t *Q, *Kr, *KT, *VT, *OG, *ZA, *HB, *GA, *GB; const float* bias; const float* convw; float* SB; int ldhb; LAS unsigned char* tlds;
    __device__ __forceinline__ void stage_consts(const Unit& u, LAS unsigned char* lds, int lane) const {
        LAS unsigned char* cb = tlds + 9216 + 2048 * u.par;
        __builtin_amdgcn_global_load_lds((const unsigned*)(bias + u.pn * BM + 4 * lane), (LAS unsigned*)cb, 16, 0, 0);
        if (u.pn >= 32 && u.pn < 64) {
#pragma unroll
            for (int tap = 0; tap < 3; ++tap) __builtin_amdgcn_global_load_lds((const unsigned*)(convw + tap * 2048 + 64 * (u.pn - 32) + lane), (LAS unsigned*)(cb + 1024 + 256 * tap), 4, 0, 0);
        }
        (void)lds;
    }
    __device__ __forceinline__ void operator()(f32x4 (&acc)[2][2][4][2], const Unit& u, int wr, int wc, int fr, int fq) const {
        const int pn = u.pn;
        const LAS float* cbias = (const LAS float*)(tlds + 9216 + 2048 * u.par) + wc * 32 + 8 * fq;
        const LAS float* ctap = (const LAS float*)(tlds + 9216 + 2048 * u.par + 1024) + 16 * wc + 4 * fq;
        const int row0 = u.pm * BM + wr * 64 + fr;
        const int bcol0 = pn * BM + wc * 32 + 8 * fq;
        if (pn >= 32 && pn < 64) {
            const int ch0 = 64 * (pn - 32) + 16 * wc + 4 * fq;
            const f32x4 w0 = *(const LAS f32x4*)(ctap), w1 = *(const LAS f32x4*)(ctap + 64), w2 = *(const LAS f32x4*)(ctap + 128);
            const f32x4 bu = *(const LAS f32x4*)(cbias), bB = *(const LAS f32x4*)(cbias + 4), bC = *(const LAS f32x4*)(cbias + HALF), bz = *(const LAS f32x4*)(cbias + HALF + 4);
            const int lane = fq * 16 + fr;
            const int src1 = (lane & 48) | ((fr + 15) & 15), src2 = (lane & 48) | ((fr + 14) & 15);
#pragma unroll
            for (int ai = 0; ai < 2; ++ai) {
                f32x4 pr1 = (f32x4){0.f, 0.f, 0.f, 0.f}, pr2 = pr1;
                const int g = u.pm * 4 + ai * 2 + wr;
                float* sb = SB + (size_t)g * 6 * 2048 + ch0;
#pragma unroll
                for (int m = 0; m < 4; ++m) {
                    const f32x4 uu = acc[ai][0][m][0] + bu, Bv = acc[ai][0][m][1] + bB, Cv = acc[ai][1][m][0] + bC, zb = acc[ai][1][m][1] + bz;
                    f32x4 cu, bzv, r1, r2, p1, p2, hb;
#pragma unroll
                    for (int e = 0; e < 4; ++e) { cu[e] = Cv[e] * uu[e]; bzv[e] = Bv[e] * silu_f(zb[e]); }
#pragma unroll
                    for (int e = 0; e < 4; ++e) { r1[e] = __shfl(cu[e], src1); r2[e] = __shfl(cu[e], src2); }
#pragma unroll
                    for (int e = 0; e < 4; ++e) { p1[e] = fr >= 1 ? r1[e] : pr1[e]; p2[e] = fr >= 2 ? r2[e] : pr2[e]; }
                    const f32x4 cv = w0 * p2 + w1 * p1 + w2 * cu;
                    hb = bzv * cv;
                    u32x2 w; w.x = pk_bf16(hb[0], hb[1]); w.y = pk_bf16(hb[2], hb[3]);
                    *(u32x2*)(HB + ktm((size_t)(row0 + ai * HALF + m * 16), 2048 + ch0, 64)) = w;
                    if (m == 0 && fr < 2) { *(f32x4*)(sb + (2 + fr) * 2048) = bzv; *(f32x4*)(sb + (4 + fr) * 2048) = cv; }
                    if (m == 3 && fr >= 14) { *(f32x4*)(sb + (fr - 14) * 2048) = cu; }
                    pr1 = r1; pr2 = r2;
                }
            }
            return;
        }
        int kind, colt, act = 0; float sc = 1.f; bf16_t* dst = nullptr; bf16_t* dstT = nullptr;
        if (pn < 4) { kind = 0; dst = Q; colt = pn * BM; sc = 0.08838834764831845f; }
        else if (pn < 8) { kind = 1; dst = Kr; dstT = KT; colt = (pn - 4) * BM; }
        else if (pn < 16) { kind = 2; dstT = VT; colt = (pn - 8) * BM; }
        else if (pn < 24) { kind = 3; dst = OG; colt = (pn - 16) * BM; act = 1; }
        else if (pn < 32) { kind = 4; dst = ZA; colt = (pn - 24) * BM; act = 2; }
        else {
            const int ch0 = 128 * (pn - 64) + wc * 32 + 8 * fq;
            f32x4 ba[2], bb[2];
#pragma unroll
            for (int n = 0; n < 2; ++n) { ba[n] = *(const LAS f32x4*)(cbias + 4 * n); bb[n] = *(const LAS f32x4*)(cbias + HALF + 4 * n); }
#pragma unroll
            for (int ai = 0; ai < 2; ++ai)
#pragma unroll
                for (int m = 0; m < 4; ++m) {
                    const size_t off = ((((((size_t)(u.pm * 2 + ai) * 2 + wr) * 4 + m) * 16 + (pn - 64)) * 4 + wc) * 64 + fq * 16 + fr) * 8;
                    float rr[8], gg[8];
#pragma unroll
                    for (int n = 0; n < 2; ++n)
#pragma unroll
                        for (int e = 0; e < 4; ++e) {
                            const float ea = __builtin_amdgcn_exp2f((acc[ai][0][m][n][e] + ba[n][e]) * -1.4426950408889634f), eb = __builtin_amdgcn_exp2f((acc[ai][1][m][n][e] + bb[n][e]) * -1.4426950408889634f);
                            rr[4 * n + e] = (1.f + eb) * __builtin_amdgcn_rcpf(1.f + ea); gg[4 * n + e] = __builtin_amdgcn_rcpf(1.f + eb);
                        }
                    u32x4 wr_, wg_;
                    wr_.x = pk_bf16(rr[0], rr[1]); wr_.y = pk_bf16(rr[2], rr[3]); wr_.z = pk_bf16(rr[4], rr[5]); wr_.w = pk_bf16(rr[6], rr[7]);
                    wg_.x = pk_bf16(gg[0], gg[1]); wg_.y = pk_bf16(gg[2], gg[3]); wg_.z = pk_bf16(gg[4], gg[5]); wg_.w = pk_bf16(gg[6], gg[7]);
                    *(u32x4*)(GA + off) = wr_; *(u32x4*)(GB + off) = wg_;
                }
            return;
        }
        const int col0 = colt + wc * 32 + 8 * fq;
        f32x4 bv[2][2];
#pragma unroll
        for (int bj = 0; bj < 2; ++bj)
#pragma unroll
            for (int n = 0; n < 2; ++n) bv[bj][n] = *(const LAS f32x4*)(cbias + bj * HALF + 4 * n);
        if (kind != 2) {
#pragma unroll
        for (int ai = 0; ai < 2; ++ai)
#pragma unroll
            for (int m = 0; m < 4; ++m) {
                const int row = row0 + ai * HALF + m * 16;
                const int cidx = row >> 6, tau = row & 63;
#pragma unroll
                for (int bj = 0; bj < 2; ++bj) {
                    f32x4 v0 = acc[ai][bj][m][0] + bv[bj][0], v1 = acc[ai][bj][m][1] + bv[bj][1];
                    if (act == 1) {
#pragma unroll
                        for (int e = 0; e < 4; ++e) { v0[e] = sigmoid_f(v0[e]); v1[e] = sigmoid_f(v1[e]); }
                    } else if (act == 2) {
#pragma unroll
                        for (int e = 0; e < 4; ++e) { v0[e] = silu_f(v0[e]); v1[e] = silu_f(v1[e]); }
                    } else { v0 = v0 * sc; v1 = v1 * sc; }
                    u32x4 w; w.x = pk_bf16(v0[0], v0[1]); w.y = pk_bf16(v0[2], v0[3]); w.z = pk_bf16(v1[0], v1[1]); w.w = pk_bf16(v1[2], v1[3]);
                    const int c0 = col0 + bj * HALF;
                    if (kind <= 1) {
                        const int hh = c0 >> 7, dk0 = c0 & 127;
                        const size_t fi = ((((size_t)((cidx >> 6) * 8 + hh) * 64 + (cidx & 63)) * 2 + (tau >> 5)) * 8 + (dk0 >> 4)) * 64 + ((dk0 >> 3) & 1) * 32 + (tau & 31);
                        *(u32x4*)(dst + fi * 8) = w;
                    } else {
                        const int hh = c0 >> 8, d8 = (c0 & 255) >> 3;
                        const size_t fi = ((((size_t)((cidx >> 6) * 8 + hh) * 64 + (cidx & 63)) * 2 + (tau >> 5)) * 32 + d8) * 64 + (tau & 31);
                        *(u32x2*)(dst + fi * 4) = (u32x2){w.x, w.y}; *(u32x2*)(dst + (fi + 32) * 4) = (u32x2){w.z, w.w};
                    }
                }
            }
        }
        if (kind == 1 || kind == 2) {
            const int hshift = kind == 1 ? 7 : 8, nblk = kind == 1 ? 4 : 8;
            const int lane = fq * 16 + fr;
            LAS unsigned char* my = tlds + (wr * 4 + wc) * 1152;
            LAS unsigned char* wp = my + (4 * fq) * 72 + fr * 2;
            const LAS unsigned char* rp = my + (lane >> 2) * 72 + ((lane >> 1) & 1) * 32 + (lane & 1) * 8;
            const int ccol0 = colt + wc * 32 + 8 * (lane >> 4) + ((lane >> 2) & 3);
            const int rrow0 = u.pm * BM + wr * 64;
#pragma unroll
            for (int ai = 0; ai < 2; ++ai)
#pragma unroll
                for (int bj = 0; bj < 2; ++bj)
#pragma unroll
                    for (int n = 0; n < 2; ++n)
#pragma unroll
                        for (int mp = 0; mp < 2; ++mp) {
#pragma unroll
                            for (int mm = 0; mm < 2; ++mm) {
                                const f32x4 v = acc[ai][bj][2 * mp + mm][n] + bv[bj][n];
                                const unsigned p01 = pk_bf16(v[0], v[1]), p23 = pk_bf16(v[2], v[3]);
                                *(LAS unsigned short*)(wp + 0 * 72 + 32 * mm) = (unsigned short)(p01 & 0xffffu); *(LAS unsigned short*)(wp + 1 * 72 + 32 * mm) = (unsigned short)(p01 >> 16);
                                *(LAS unsigned short*)(wp + 2 * 72 + 32 * mm) = (unsigned short)(p23 & 0xffffu); *(LAS unsigned short*)(wp + 3 * 72 + 32 * mm) = (unsigned short)(p23 >> 16);
                            }
                            asm volatile("" ::: "memory");
                            const u32x2 lo = *(const LAS u32x2*)(rp), hi = *(const LAS u32x2*)(rp + 16);
                            asm volatile("" ::: "memory");
                            const int rr = rrow0 + ai * HALF + 32 * mp, cidx = rr >> 6, ks = ((rr & 63) >> 4) + ((lane >> 1) & 1);
                            const int cc = ccol0 + bj * HALF + 4 * n, hh = cc >> hshift, rowi = cc & ((1 << hshift) - 1);
                            const size_t fi = ((((size_t)((cidx >> 6) * 8 + hh) * 64 + (cidx & 63)) * nblk + (rowi >> 5)) * 4 + ks) * 64 + (lane & 1) * 32 + (rowi & 31);
                            *(u32x4*)(dstT + fi * 8) = (u32x4){lo.x, lo.y, hi.x, hi.y};
                        }
        }
    }
};

struct MergeOrder {
    StaticOrder so;
    __device__ bool next(int i, Unit& u) const { if (!so.next(i >> 1, u)) return false; u.which = i & 1; return true; }
};
struct EpiMerge {
    static __device__ __forceinline__ bool keeps_acc(const Unit& u) { return u.which == 0; }
    static constexpr bool PERM = true; static constexpr bool LDS_CONST = false; static constexpr bool KHOOK = false;
    const bf16_t* RR; const bf16_t* GB; bf16_t* MG;
    __device__ __forceinline__ void operator()(f32x4 (&acc)[2][2][4][2], const Unit& u, int wr, int wc, int fr, int fq) const {
        const int row0 = u.pm * BM + wr * 64 + fr, col0 = u.pn * BM + wc * 32 + 8 * fq;
        const bf16_t* src = u.which == 0 ? RR : GB;
        u32x4 gv[2][4][2];
#pragma unroll
        for (int ai = 0; ai < 2; ++ai)
#pragma unroll
            for (int m = 0; m < 4; ++m)
#pragma unroll
                for (int bj = 0; bj < 2; ++bj) gv[ai][m][bj] = *(const u32x4*)(src + ((((((size_t)(u.pm * 2 + ai) * 2 + wr) * 4 + m) * 16 + (2 * u.pn + bj)) * 4 + wc) * 64 + fq * 16 + fr) * 8);
        asm volatile("" ::: "memory");
#pragma unroll
        for (int ai = 0; ai < 2; ++ai)
#pragma unroll
            for (int m = 0; m < 4; ++m) {
#pragma unroll
                for (int bj = 0; bj < 2; ++bj) {
                    const size_t off = ktm((size_t)(row0 + ai * HALF + m * 16), col0 + bj * HALF, 32);
                    const u32x4 g = gv[ai][m][bj];
                    f32x4 g0 = {bf_lo(g.x), bf_hi(g.x), bf_lo(g.y), bf_hi(g.y)}, g1 = {bf_lo(g.z), bf_hi(g.z), bf_lo(g.w), bf_hi(g.w)};
                    const f32x4 t0 = acc[ai][bj][m][0] * g0, t1 = acc[ai][bj][m][1] * g1;
                    if (u.which == 0) { acc[ai][bj][m][0] = t0; acc[ai][bj][m][1] = t1; }
                    else { u32x4 w; w.x = pk_bf16(t0[0], t0[1]); w.y = pk_bf16(t0[2], t0[3]); w.z = pk_bf16(t1[0], t1[1]); w.w = pk_bf16(t1[2], t1[3]); *(u32x4*)(MG + off) = w; }
                }
            }
    }
};
struct PanelOrder {
    int vcu;
    __device__ bool next(int i, Unit& u) const { if (i >= 2) return false; u.pm = 32 * i + (vcu >> 3); u.pn = vcu & 7; u.which = 0; return true; }
};
struct EpiOutNorm {
    static __device__ __forceinline__ bool keeps_acc(const Unit&) { return false; }
    static constexpr bool PERM = false; static constexpr bool LDS_CONST = false; static constexpr bool KHOOK = true;
    const float* X; const float* gate; const float* nfw; float* O; float* rowss; unsigned* cnt;
    __device__ __forceinline__ const float* hook_base(const Unit& u) const { return X + (size_t)(u.pm * BM) * DM + u.pn * BM; }
    __device__ __forceinline__ void operator()(f32x4 (&acc)[2][2][4][2], const Unit& u, int wr, int wc, int fr, int fq) const {
        asm volatile("" : "+v"(fr), "+v"(fq));
        const int row0 = u.pm * BM + wr * 64 + fr, col0 = u.pn * BM + wc * 32 + 4 * fq;
        float rs[2][4];
#pragma unroll
        for (int ai = 0; ai < 2; ++ai)
#pragma unroll
            for (int m = 0; m < 4; ++m) {
                float q = 0.f;
#pragma unroll
                for (int bj = 0; bj < 2; ++bj)
#pragma unroll
                    for (int n = 0; n < 2; ++n) { const f32x4 v = acc[ai][bj][m][n]; q += (v[0] * v[0] + v[1] * v[1]) + (v[2] * v[2] + v[3] * v[3]); }
                q += __shfl_xor(q, 16); q += __shfl_xor(q, 32);
                rs[ai][m] = q;
            }
        float sink = 0.f;
        if (fq == 0) {
#pragma unroll
            for (int ai = 0; ai < 2; ++ai)
#pragma unroll
                for (int m = 0; m < 4; ++m) sink += __hip_atomic_fetch_add(rowss + row0 + ai * HALF + m * 16, rs[ai][m], __ATOMIC_RELAXED, __HIP_MEMORY_SCOPE_AGENT);
        }
        asm volatile("s_waitcnt vmcnt(0)" :: "v"(sink) : "memory");
        unsigned* cp = cnt + 64 * u.pm;
        if (fq == 0 && fr == 0) (void)__hip_atomic_fetch_add(cp, 1u, __ATOMIC_RELAXED, __HIP_MEMORY_SCOPE_AGENT);
        {
            unsigned spins = 0;
            while ((unsigned)__builtin_amdgcn_readfirstlane(__hip_atomic_load(cp, __ATOMIC_RELAXED, __HIP_MEMORY_SCOPE_AGENT)) < 64u) { __builtin_amdgcn_s_sleep(2); if (++spins > (1u << 22)) break; }
        }
        asm volatile("" ::: "memory");
        float rstd[2][4];
#pragma unroll
        for (int ai = 0; ai < 2; ++ai)
#pragma unroll
            for (int m = 0; m < 4; ++m) rstd[ai][m] = rsqrtf(__hip_atomic_load(rowss + row0 + ai * HALF + m * 16, __ATOMIC_RELAXED, __HIP_MEMORY_SCOPE_AGENT) * (1.f / DM) + EPS);
        f32x4 wv[2][2];
#pragma unroll
        for (int bj = 0; bj < 2; ++bj)
#pragma unroll
            for (int n = 0; n < 2; ++n) wv[bj][n] = *(const f32x4*)(nfw + col0 + bj * HALF + n * 16);
        const bool lo8 = fr < 8;
        float* oA = O + (size_t)(u.pm * BM + wr * 64 + (fr & 7)) * DM + u.pn * BM + wc * 32 + 4 * fq + (lo8 ? 0 : 16);
        float* oB = O + (size_t)(u.pm * BM + wr * 64 + 8 + (fr & 7)) * DM + u.pn * BM + wc * 32 + 4 * fq + (lo8 ? 16 : 0);
#pragma unroll
        for (int ai = 0; ai < 2; ++ai)
#pragma unroll
            for (int m = 0; m < 4; ++m) {
                const size_t off = (size_t)(ai * HALF + m * 16) * DM;
#pragma unroll
                for (int bj = 0; bj < 2; ++bj) {
                    const f32x4 v0 = acc[ai][bj][m][0] * rstd[ai][m] * wv[bj][0], v1 = acc[ai][bj][m][1] * rstd[ai][m] * wv[bj][1];
                    const f32x4 t1 = ror8(v1);
                    f32x4 dA, dB;
#pragma unroll
                    for (int e = 0; e < 4; ++e) { dA[e] = lo8 ? v0[e] : t1[e]; dB[e] = lo8 ? t1[e] : v0[e]; }
                    *(f32x4*)(oA + off + bj * HALF) = dA; *(f32x4*)(oB + off + bj * HALF) = dB;
                }
            }
    }
};
}

constexpr size_t MiB = 1u << 20;
constexpr size_t WS_CTL = 0, CTL_ZERO_BYTES = 73728 * 4;
constexpr size_t WS_MISC = 1 * MiB;
constexpr size_t WS_WINT = 8 * MiB;
constexpr size_t WS_H = 88 * MiB;
constexpr size_t WS_CT = 8 * MiB;
constexpr size_t WS_MG = 8 * MiB;
constexpr size_t WS_WAB = 152 * MiB;
constexpr size_t WS_WO = 168 * MiB;
constexpr size_t WS_Q = 176 * MiB, WS_K = 208 * MiB, WS_VT = 240 * MiB, WS_KT = 304 * MiB;
constexpr size_t WS_OG = 336 * MiB, WS_ZA = 400 * MiB, WS_HAB = 464 * MiB;
constexpr size_t WS_SB = 592 * MiB;
constexpr size_t WS_WOS = 604 * MiB;
constexpr size_t WS_END = 636 * MiB;
constexpr int CW_BAR = 0;
constexpr int CW_MOD = 28672;
constexpr int CW_ROWSS = 53248;
constexpr int CW_CNT = 69632;
constexpr size_t MI_BPERM = 0;
constexpr size_t MI_AMX = 32768, MI_GS = MI_AMX + 4096, MI_MS = MI_GS + 4096;
constexpr size_t MI_AA = 65536, MI_CM = MI_AA + 131072, MI_BB = MI_CM + 131072;
constexpr size_t MI_NJ = MI_BB + 131072;
constexpr size_t MI_WIF = MI_NJ + 262144;
static_assert((MI_WIF + 32768) * 4 <= 7 * MiB, "misc map");

constexpr int NWAVES = 8;
constexpr int LDS_BYTES = 147456;

#define GAS __attribute__((address_space(1)))
typedef GAS unsigned gu32;
#define RLX_AGENT __ATOMIC_RELAXED, __HIP_MEMORY_SCOPE_AGENT

#define XB_TMO      128
#define XB_XCNT(j)  (256  + 64 * (j))
#define XB_XSUB(j)  (1280 + 64 * (j))
#define XB_XGEN(j)  (2304 + 64 * (j))
#define XB_TOP      3328
#define XB_TOPGEN   3392
#define XCD_BAR_WORDS 3456
#define XB_SPIN_CAP (1u << 18)
__device__ __forceinline__ unsigned xb_ld(unsigned* p)              { return __hip_atomic_load(p, __ATOMIC_RELAXED, __HIP_MEMORY_SCOPE_AGENT); }
__device__ __forceinline__ unsigned xb_add(unsigned* p, unsigned v) { return __hip_atomic_fetch_add(p, v, __ATOMIC_RELAXED, __HIP_MEMORY_SCOPE_AGENT); }
__device__ __forceinline__ unsigned xb_xcc_id() { return (unsigned)__builtin_amdgcn_s_getreg((3 << 11) | 20) & 0xFu; }
#define XB_SPIN(cond, bar) do { unsigned _sp = 0; while (cond) { __builtin_amdgcn_s_sleep(1); \
    if ((++_sp & 255u) == 0u) { if (xb_ld(&(bar)[XB_TMO])) break; if (_sp > XB_SPIN_CAP) { atomicAdd(&(bar)[XB_TMO], 1u); break; } } } } while (0)
struct XcdBarrier { unsigned* bar; unsigned x; volatile LAS unsigned* st; };
__device__ __forceinline__ XcdBarrier xcd_barrier_post(unsigned* bar, volatile LAS unsigned* st) {
    XcdBarrier b; b.bar = bar; b.x = xb_xcc_id(); b.st = st;
    if (threadIdx.x == 0) (void)xb_add(&bar[XB_XCNT(b.x)], 1u);
    return b;
}
__device__ __forceinline__ void xcd_barrier_complete(unsigned* bar, unsigned x, unsigned& nloc, unsigned& nx) {
    const unsigned G = gridDim.x * gridDim.y * gridDim.z;
    unsigned sum, cnt, mine, sp = 0u;
    for (;;) {
        sum = 0u; cnt = 0u; mine = 0u;
#pragma unroll
        for (unsigned j = 0; j < 16; ++j) { const unsigned c = xb_ld(&bar[XB_XCNT(j)]); sum += c; cnt += (c > 0u) ? 1u : 0u; mine = (j == x) ? c : mine; }
        if (sum == G) break;
        __builtin_amdgcn_s_sleep(1);
        if ((++sp & 255u) == 0u) { if (xb_ld(&bar[XB_TMO])) break; if (sp > XB_SPIN_CAP) { atomicAdd(&bar[XB_TMO], 1u); break; } }
    }
    nloc = mine > 0u ? mine : 1u; nx = cnt > 0u ? cnt : 1u;
}
__device__ __forceinline__ void xcd_barrier(const XcdBarrier& b) {
    asm volatile("s_waitcnt vmcnt(0)" ::: "memory");
    __syncthreads();
    if (threadIdx.x == 0) {
        unsigned* bar = b.bar;
        __builtin_amdgcn_s_waitcnt(0);
        unsigned nloc = b.st[0], nx = b.st[1];
        if (nloc == 0u) { xcd_barrier_complete(bar, b.x, nloc, nx); b.st[0] = nloc; b.st[1] = nx; }
        const unsigned old = xb_add(&bar[XB_XSUB(b.x)], 1u);
        const unsigned gen = old / nloc;
        if (old + 1u == (gen + 1u) * nloc) {
            __builtin_amdgcn_fence(__ATOMIC_RELEASE, "agent");
            asm volatile("s_waitcnt vmcnt(0)" ::: "memory");
            const unsigned og = xb_add(&bar[XB_TOP], 1u);
            const unsigned tg = og / nx;
            if (og + 1u == (tg + 1u) * nx) xb_add(&bar[XB_TOPGEN], 1u);
            else XB_SPIN(xb_ld(&bar[XB_TOPGEN]) == tg, bar);
            __builtin_amdgcn_fence(__ATOMIC_ACQUIRE, "agent");
            xb_add(&bar[XB_XGEN(b.x)], 1u);
            asm volatile("s_waitcnt vmcnt(0)" ::: "memory");
        } else {
            XB_SPIN(xb_ld(&bar[XB_XGEN(b.x)]) == gen, bar);
            __builtin_amdgcn_fence(__ATOMIC_ACQUIRE, "agent");
            asm volatile("s_waitcnt vmcnt(0)" ::: "memory");
        }
    }
    __syncthreads();
}

struct Args { const float* in[13]; float* out; unsigned char* ws; int ph_lo, ph_hi, li, pad; };

template <class ColFn>
__device__ __forceinline__ void p0_transpose_item(const float* W, int ldw, bf16_t* WT, int ldt, int koff, int k0, int n0, ColFn colfn, LAS float* scr, int lane) {
    const int sc = colfn(n0 + 4 * (lane & 7));
    f32x4 v[8];
#pragma unroll
    for (int i = 0; i < 8; ++i) v[i] = *(const f32x4*)(W + (size_t)(k0 + 8 * i + (lane >> 3)) * ldw + sc);
#pragma unroll
    for (int i = 0; i < 8; ++i) { LAS float* d = scr + (8 * i + (lane >> 3)) * 33 + 4 * (lane & 7); d[0] = v[i][0]; d[1] = v[i][1]; d[2] = v[i][2]; d[3] = v[i][3]; }
    asm volatile("s_waitcnt lgkmcnt(0)" ::: "memory");
    const int c = lane & 7;
#pragma unroll
    for (int j = 0; j < 4; ++j) { const int n = (lane >> 3) + 8 * j; const LAS float* s = scr + (8 * c) * 33 + n;
        u32x4 o; o.x = pk_bf16(s[0 * 33], s[1 * 33]); o.y = pk_bf16(s[2 * 33], s[3 * 33]); o.z = pk_bf16(s[4 * 33], s[5 * 33]); o.w = pk_bf16(s[6 * 33], s[7 * 33]);
        *(u32x4*)(WT + (size_t)(n0 + n) * ldt + koff + k0 + 8 * c) = o; }
    asm volatile("s_waitcnt lgkmcnt(0)" ::: "memory");
}

struct P0Item { const float* src; bf16_t* dst; int ldw, ldt; };
__device__ __forceinline__ P0Item p0_item(const Args& a, unsigned char* ws, int it, int lane) {
    constexpr int I_IN = 32 * 640, I_SQ = 32 * 64;
    P0Item p;
    if (it < I_IN) {
        const int kb = it / 640, nb = it % 640;
        p.src = a.in[5] + (size_t)(64 * kb) * INW + win_src_col(32 * nb + 4 * (lane & 7)); p.ldw = INW;
        p.dst = (bf16_t*)(ws + WS_WINT) + pg8::ktm((size_t)(32 * nb), 64 * kb, 32); p.ldt = 64;
    } else {
        const int r0 = it - I_IN, mat = r0 / I_SQ, r = r0 % I_SQ, kb = r / 64, nb = r % 64;
        const float* W = mat == 0 ? a.in[9] : a.in[10];
        p.src = W + (size_t)(64 * kb) * DM + 32 * nb + 4 * (lane & 7); p.ldw = DM;
        p.ldt = 64;
        p.dst = (bf16_t*)(ws + WS_WAB) + pg8::ktm((size_t)(32 * nb), (mat == 1 ? 2048 : 0) + 64 * kb, 64);
    }
    return p;
}
__device__ __forceinline__ void p0_item_load(const P0Item& p, f32x4 (&v)[8], int lane) {
#pragma unroll
    for (int i = 0; i < 8; ++i) v[i] = *(const f32x4*)(p.src + (size_t)(8 * i + (lane >> 3)) * p.ldw);
}
__device__ __forceinline__ void p0_item_finish(const P0Item& p, const f32x4 (&v)[8], LAS float* scr, int lane) {
#pragma unroll
    for (int i = 0; i < 8; ++i) { LAS float* d = scr + (8 * i + (lane >> 3)) * 33 + 4 * (lane & 7); d[0] = v[i][0]; d[1] = v[i][1]; d[2] = v[i][2]; d[3] = v[i][3]; }
    asm volatile("s_waitcnt lgkmcnt(0)" ::: "memory");
    const int c = lane & 7;
#pragma unroll
    for (int j = 0; j < 4; ++j) { const int n = (lane >> 3) + 8 * j; const LAS float* sp = scr + (8 * c) * 33 + n;
        u32x4 o; o.x = pk_bf16(sp[0 * 33], sp[1 * 33]); o.y = pk_bf16(sp[2 * 33], sp[3 * 33]); o.z = pk_bf16(sp[4 * 33], sp[5 * 33]); o.w = pk_bf16(sp[6 * 33], sp[7 * 33]);
        *(u32x4*)(p.dst + (size_t)n * p.ldt + 8 * c) = o; }
    asm volatile("s_waitcnt lgkmcnt(0)" ::: "memory");
}

__device__ __forceinline__ void p0_prep(const Args& a, LAS unsigned char* lds, int tid, int lane, int wave, int vcu, int G) {
    unsigned char* ws = a.ws;
    const float* c_in = a.in[1]; const float* w_ada = a.in[3]; const float* b_ada = a.in[4]; const float* w_in = a.in[5]; const float* b_in = a.in[6];
    float* MOD = (float*)(ws + WS_CTL) + CW_MOD;
    {
        const int bx = blockIdx.x, cg = bx & 7, ks = bx >> 3;
        if (ks < 32) {
            LAS float* cact = (LAS float*)(lds + 100 * 1024);
            if (tid < 256) { const int b = tid >> 6, kk = tid & 63; cact[tid] = silu_acc(c_in[b * DM + ks * 64 + kk]); }
            f32x4 wv[8][3];
#pragma unroll
            for (int kk = 0; kk < 8; ++kk)
#pragma unroll
                for (int j = 0; j < 3; ++j) wv[kk][j] = *(const f32x4*)(w_ada + (size_t)(ks * 64 + wave * 8 + kk) * 6144 + cg * 768 + 256 * j + 4 * lane);
            __syncthreads();
            f32x4 acc[4][3];
#pragma unroll
            for (int b = 0; b < 4; ++b)
#pragma unroll
                for (int j = 0; j < 3; ++j) acc[b][j] = (f32x4){0.f, 0.f, 0.f, 0.f};
#pragma unroll
            for (int kk = 0; kk < 8; ++kk) {
                float ca[4];
#pragma unroll
                for (int b = 0; b < 4; ++b) ca[b] = cact[b * 64 + wave * 8 + kk];
#pragma unroll
                for (int j = 0; j < 3; ++j)
#pragma unroll
                    for (int b = 0; b < 4; ++b) acc[b][j] += wv[kk][j] * ca[b];
            }
            LAS f32x4* red = (LAS f32x4*)lds;
#pragma unroll
            for (int b = 0; b < 4; ++b)
#pragma unroll
                for (int j = 0; j < 3; ++j) red[(wave * 12 + b * 3 + j) * 64 + lane] = acc[b][j];
            __syncthreads();
            for (int idx = tid; idx < 768; idx += 512) {
                const int bj = idx >> 6, ln = idx & 63, b = bj / 3, j = bj % 3;
                f32x4 s = (f32x4){0.f, 0.f, 0.f, 0.f};
#pragma unroll
                for (int w = 0; w < 8; ++w) s += red[(w * 12 + bj) * 64 + ln];
                const int col = cg * 768 + 256 * j + 4 * ln;
                if (ks == 0) s += *(const f32x4*)(b_ada + col);
                float* mp = MOD + b * 6144 + col;
                atomicAdd(mp + 0, s[0]); atomicAdd(mp + 1, s[1]); atomicAdd(mp + 2, s[2]); atomicAdd(mp + 3, s[3]);
            }
            __syncthreads();
        }
    }
    {
        LAS float* scr = (LAS float*)(lds + wave * 16384);
        const int gw = vcu * NWAVES + wave, NGW = G * NWAVES;
        constexpr int NITEMS = 32 * 640 + 2 * 32 * 64;
        if (NGW * 12 == NITEMS) {
            P0Item I0 = p0_item(a, ws, gw, lane), I1;
            f32x4 v0[8], v1[8];
            p0_item_load(I0, v0, lane);
#pragma unroll 1
            for (int k = 0; k < 10; k += 2) {
                I1 = p0_item(a, ws, gw + (k + 1) * NGW, lane); p0_item_load(I1, v1, lane); p0_item_finish(I0, v0, scr, lane);
                I0 = p0_item(a, ws, gw + (k + 2) * NGW, lane); p0_item_load(I0, v0, lane); p0_item_finish(I1, v1, scr, lane);
            }
            I1 = p0_item(a, ws, gw + 11 * NGW, lane); p0_item_load(I1, v1, lane); p0_item_finish(I0, v0, scr, lane);
            p0_item_finish(I1, v1, scr, lane);
        } else {
            for (int it = gw; it < NITEMS; it += NGW) { const P0Item I = p0_item(a, ws, it, lane); f32x4 v[8]; p0_item_load(I, v, lane); p0_item_finish(I, v, scr, lane); }
        }
        float* bperm = (float*)(ws + WS_MISC) + MI_BPERM;
        for (int i = blockIdx.x * 512 + tid; i < NPRJ; i += G * 512) bperm[i] = b_in[win_src_col(i)];
        float* wif = (float*)(ws + WS_MISC) + MI_WIF;
        for (int i = blockIdx.x * 512 + tid; i < 2048 * 16; i += G * 512) wif[i] = w_in[(size_t)(i >> 4) * INW + O_IF + (i & 15)];
    }
}

__device__ __forceinline__ void p1_hnorm(const Args& a, LAS unsigned char* lds, int tid, int lane, int wave, int G) {
    unsigned char* ws = a.ws;
    const float* x = a.in[0]; const float* nw = a.in[2]; const float* w_in = a.in[5]; const float* b_in = a.in[6];
    const float* MOD = (const float*)(ws + WS_CTL) + CW_MOD;
    bf16_t* Hb = (bf16_t*)(ws + WS_H);
    float* misc = (float*)(ws + WS_MISC);
    LAS f32x4* wl = (LAS f32x4*)lds;
    LAS float* gl = (LAS float*)(lds + 131072);
    for (int it = blockIdx.x * NWAVES + wave; it < 32 * 64; it += G * NWAVES) {
        const int kb = it / 64, nb = it % 64;
        LAS float* scr = (LAS float*)(lds + wave * 16384);
        const float* src = a.in[11] + (size_t)(64 * kb) * DM + 32 * nb + 4 * (lane & 7);
        f32x4 v[8];
#pragma unroll
        for (int i = 0; i < 8; ++i) v[i] = *(const f32x4*)(src + (size_t)(8 * i + (lane >> 3)) * DM);
        float gt[4][4];
#pragma unroll
        for (int j = 0; j < 4; ++j)
#pragma unroll
            for (int bb = 0; bb < 4; ++bb) gt[j][bb] = MOD[bb * 6144 + 4096 + 32 * nb + (lane >> 3) + 8 * j];
#pragma unroll
        for (int i = 0; i < 8; ++i) { LAS float* d = scr + (8 * i + (lane >> 3)) * 33 + 4 * (lane & 7); d[0] = v[i][0]; d[1] = v[i][1]; d[2] = v[i][2]; d[3] = v[i][3]; }
        asm volatile("s_waitcnt lgkmcnt(0)" ::: "memory");
        const int c = lane & 7;
#pragma unroll
        for (int j = 0; j < 4; ++j) {
            const int n = (lane >> 3) + 8 * j; const LAS float* sp = scr + (8 * c) * 33 + n;
            float e[8];
#pragma unroll
            for (int q = 0; q < 8; ++q) e[q] = sp[q * 33];
#pragma unroll
            for (int bb = 0; bb < 4; ++bb) {
                const float gg = gt[j][bb];
                u32x4 o; o.x = pk_bf16(e[0] * gg, e[1] * gg); o.y = pk_bf16(e[2] * gg, e[3] * gg); o.z = pk_bf16(e[4] * gg, e[5] * gg); o.w = pk_bf16(e[6] * gg, e[7] * gg);
                *(u32x4*)((bf16_t*)(ws + WS_WOS) + (size_t)bb * DM * DM + pg8::ktm((size_t)(32 * nb + n), 64 * kb + 8 * c, 32)) = o;
            }
        }
        asm volatile("s_waitcnt lgkmcnt(0)" ::: "memory");
    }
    __syncthreads();
    {
        const f32x4* wif4 = (const f32x4*)(misc + MI_WIF);
#pragma unroll 1
        for (int hb = 0; hb < 2; ++hb) {
            f32x4 wq[8];
#pragma unroll
            for (int i = 0; i < 8; ++i) wq[i] = wif4[tid + 512 * (8 * hb + i)];
#pragma unroll
            for (int i = 0; i < 8; ++i) { const int q4 = tid + 512 * (8 * hb + i), k = q4 >> 2, gq = q4 & 3, e = k & 3, l = (k >> 2) & 63, jx = k >> 8; wl[((e * 8 + jx) * 4 + gq) * 64 + l] = wq[i]; }
        }
    }
    __syncthreads();
    const int gw = blockIdx.x * NWAVES + wave;
    const int rbase = gw * 8, b = rbase >> 12;
    f32x4 ms[8], sh[8];
#pragma unroll
    for (int j = 0; j < 8; ++j) {
        const int k = 4 * lane + 256 * j;
        const f32x4 nv = *(const f32x4*)(nw + k), scv = *(const f32x4*)(MOD + b * 6144 + 2048 + k);
        ms[j] = nv * (scv + 1.0f); sh[j] = *(const f32x4*)(MOD + b * 6144 + k);
    }
    for (int i = 0; i < 8; ++i) {
        const int row = rbase + i;
        const f32x4* xr = (const f32x4*)(x + (size_t)row * DM) + lane;
        f32x4 v[8]; float ss = 0.f;
#pragma unroll
        for (int j = 0; j < 8; ++j) { v[j] = xr[64 * j]; ss += (v[j][0] * v[j][0] + v[j][1] * v[j][1]) + (v[j][2] * v[j][2] + v[j][3] * v[j][3]); }
        const float rstd = rsqrtf(wave_sum(ss) * (1.f / DM) + EPS);
        f32x4 acc[4];
#pragma unroll
        for (int gq = 0; gq < 4; ++gq) acc[gq] = (f32x4){0.f, 0.f, 0.f, 0.f};
        u32x2* hrow = (u32x2*)(Hb + (size_t)row * DM) + lane;
#pragma unroll
        for (int j = 0; j < 8; ++j) {
            const f32x4 hv = v[j] * rstd * ms[j] + sh[j];
            u32x2 w; w.x = pk_bf16(hv[0], hv[1]); w.y = pk_bf16(hv[2], hv[3]);
            hrow[64 * j] = w;
#pragma unroll
            for (int e = 0; e < 4; ++e)
#pragma unroll
                for (int gq = 0; gq < 4; ++gq) acc[gq] += wl[((e * 8 + j) * 4 + gq) * 64 + lane] * hv[e];
            asm volatile("" ::: "memory");
        }
        float mine = 0.f;
#pragma unroll
        for (int gq = 0; gq < 4; ++gq)
#pragma unroll
            for (int e = 0; e < 4; ++e) { const float sgs = wave_sum(acc[gq][e]); mine = (lane == gq * 4 + e) ? sgs : mine; }
        if (lane < 16) {
            const float pre = mine + b_in[O_IF + lane];
            gl[lane * 64 + wave * 8 + i] = lane < 8 ? pre : (fminf(pre, 0.f) - log1pf(expf(-fabsf(pre))));
        }
    }
    __syncthreads();
    {
        const int hh = wave, jc = blockIdx.x & 63, bh = b * 8 + hh;
        const float li = gl[hh * 64 + lane], lf = gl[(8 + hh) * 64 + lane];
        float bc = lf;
#pragma unroll
        for (int o = 1; o < 64; o <<= 1) { const float t = __shfl_up(bc, o); if (lane >= o) bc += t; }
        const float av = li - bc;
        float cm = av;
#pragma unroll
        for (int o = 1; o < 64; o <<= 1) { const float t = __shfl_up(cm, o); if (lane >= o) cm = fmaxf(cm, t); }
        const size_t ti = (size_t)bh * SEQ + jc * 64 + lane;
        misc[MI_AA + ti] = av; misc[MI_CM + ti] = cm; misc[MI_BB + ti] = bc;
        if (lane == 63) { misc[MI_AMX + bh * 64 + jc] = cm; misc[MI_GS + bh * 64 + jc] = bc; }
    }
}

__device__ __forceinline__ f32x16 mfma32(bf16x8 a, bf16x8 b, f32x16 c) { return MFMA32(a, b, c); }

__device__ __forceinline__ void p3_scan(const Args& a, LAS unsigned char* lds, int tid, int lane, int wave, int vcu, int G) {
    unsigned char* ws = a.ws;
    {
        const float* SB = (const float*)(ws + WS_SB); const float* convw = a.in[7]; bf16_t* HB = (bf16_t*)(ws + WS_HAB);
        for (int idx = blockIdx.x * 512 + tid; idx < 256 * 512; idx += G * 512) {
            const int g = idx >> 9, ch = (idx & 511) * 4;
            const float* sb = SB + (size_t)g * 6 * 2048 + ch;
            f32x4 c62 = (f32x4){0.f, 0.f, 0.f, 0.f}, c63 = c62;
            if ((g & 63) != 0) { c62 = *(const f32x4*)(sb - 6 * 2048); c63 = *(const f32x4*)(sb - 5 * 2048); }
            const f32x4 bz0 = *(const f32x4*)(sb + 2 * 2048), bz1 = *(const f32x4*)(sb + 3 * 2048), p0 = *(const f32x4*)(sb + 4 * 2048), p1 = *(const f32x4*)(sb + 5 * 2048);
            const f32x4 w0 = *(const f32x4*)(convw + ch), w1 = *(const f32x4*)(convw + 2048 + ch);
            const f32x4 h0 = bz0 * (p0 + w0 * c62 + w1 * c63), h1 = bz1 * (p1 + w0 * c63);
            u32x2 o0, o1; o0.x = pk_bf16(h0[0], h0[1]); o0.y = pk_bf16(h0[2], h0[3]); o1.x = pk_bf16(h1[0], h1[1]); o1.y = pk_bf16(h1[2], h1[3]);
            *(u32x2*)(HB + pg8::ktm((size_t)(64 * g), 2048 + ch, 64)) = o0; *(u32x2*)(HB + pg8::ktm((size_t)(64 * g + 1), 2048 + ch, 64)) = o1;
        }
    }
    const int xcd = vcu >> 5, cu = vcu & 31, slot = wave * 32 + cu;
    if (G != 256 || slot >= 144) return;
    const int bh = xcd * 4 + slot / 36, rem = slot % 36, ib = rem / 9, jv = rem % 9;
    const int b = bh >> 3, hh = bh & 7, r = lane & 31, h = lane >> 5;
    const bf16_t* KT = (const bf16_t*)(ws + WS_KT); const bf16_t* VT = (const bf16_t*)(ws + WS_VT);
    bf16_t* CT = (bf16_t*)(ws + WS_CT);
    float* misc = (float*)(ws + WS_MISC);
    const float* AAp = misc + MI_AA + (size_t)bh * SEQ + lane;
    float* NJ = misc + MI_NJ + (size_t)bh * 64 * 128;
    const bf16_t* ktp = KT + ((size_t)bh * 64 * 16 + ib * 4) * 512 + lane * 8;
    const bf16_t* vtp = VT + ((size_t)bh * 64 * 32 + (jv & 7) * 4) * 512 + lane * 8;
    LAS float* wsl = (LAS float*)(lds + wave * 256);
    float msv, m63v;
    {
        const float amx = misc[MI_AMX + bh * 64 + lane], gs = misc[MI_GS + bh * 64 + lane];
        float Gc = gs, Cc = gs + amx;
#pragma unroll
        for (int o = 1; o < 64; o <<= 1) { const float Gp = __shfl_up(Gc, o), Cp = __shfl_up(Cc, o); if (lane >= o) { Cc = fmaxf(Cp + Gc, Cc); Gc = Gp + Gc; } }
        const float mnext = fmaxf(Gc, Cc);
        msv = __shfl_up(mnext, 1); if (lane == 0) msv = 0.f;
        m63v = fmaxf(msv, amx);
        if (rem == 8) misc[MI_MS + bh * 64 + lane] = msv;
    }
    f32x16 acc;
#pragma unroll
    for (int i = 0; i < 16; ++i) acc[i] = 0.f;
    const u32x4 ones = (u32x4){ONES16, ONES16, ONES16, ONES16};
    struct OpSet { bf16x8 A[4]; u32x4 B[4]; float a; };
    auto load_set = [&](OpSet& S, int jj) {
        const int jc = jj < NCH ? jj : NCH - 1;
        S.a = AAp[64 * jc];
#pragma unroll
        for (int ks = 0; ks < 4; ++ks) { S.A[ks] = *(const bf16x8*)(ktp + (size_t)jc * 16 * 512 + 512 * ks); S.B[ks] = *(const u32x4*)(vtp + (size_t)jc * 32 * 512 + 512 * ks); }
    };
    auto step = [&](int j, const OpSet& S) {
        const float ms_j = __int_as_float(__builtin_amdgcn_readlane(__float_as_int(msv), j)), m63 = __int_as_float(__builtin_amdgcn_readlane(__float_as_int(m63v), j));
        const float wgt = __expf(S.a - m63), keep = __expf(ms_j - m63);
        wsl[lane] = wgt;
        if (jv < 8) {
            bf16_t* cp = CT + ((((size_t)(bh * 64 + j) * 8 + jv) * 8 + 2 * ib) * 64 + r) * 8 + 4 * h;
#pragma unroll
            for (int q = 0; q < 4; ++q) { u32x2 w; w.x = pk_bf16(acc[4 * q], acc[4 * q + 1]); w.y = pk_bf16(acc[4 * q + 2], acc[4 * q + 3]); *(u32x2*)(cp + ((q >> 1) * 64 + (q & 1) * 32) * 8) = w; }
        } else if (r == 0) {
            float* np = NJ + (size_t)j * 128 + 32 * ib + 4 * h;
#pragma unroll
            for (int q = 0; q < 4; ++q) *(f32x4*)(np + 8 * q) = (f32x4){acc[4 * q], acc[4 * q + 1], acc[4 * q + 2], acc[4 * q + 3]};
        }
        acc = acc * keep;
#pragma unroll
        for (int ks = 0; ks < 4; ++ks) {
            const u32x4 raw = (jv < 8) ? S.B[ks] : ones;
            const f32x4 wa = *(const LAS f32x4*)(wsl + 16 * ks + 4 * h), wb = *(const LAS f32x4*)(wsl + 16 * ks + 8 + 4 * h);
            u32x4 o;
            o.x = pk_bf16(bf_lo(raw.x) * wa[0], bf_hi(raw.x) * wa[1]); o.y = pk_bf16(bf_lo(raw.y) * wa[2], bf_hi(raw.y) * wa[3]);
            o.z = pk_bf16(bf_lo(raw.z) * wb[0], bf_hi(raw.z) * wb[1]); o.w = pk_bf16(bf_lo(raw.w) * wb[2], bf_hi(raw.w) * wb[3]);
            acc = mfma32(S.A[ks], __builtin_bit_cast(bf16x8, o), acc);
        }
    };
    OpSet S0, S1, S2, S3;
    load_set(S0, 0); load_set(S1, 1); load_set(S2, 2);
    for (int j = 0; j < NCH; j += 4) {
        load_set(S3, j + 3); step(j, S0);
        load_set(S0, j + 4); step(j + 1, S1);
        load_set(S1, j + 5); step(j + 2, S2);
        load_set(S2, j + 6); step(j + 3, S3);
    }
}

template <int LB>
__device__ __forceinline__ void p4_unit(const bf16_t* Q, const bf16_t* Kr, const bf16_t* VT, const bf16_t* CT, const bf16_t* OG, const bf16_t* ZA, bf16_t* HA,
                                        const float* misc, const float* hnw, LAS float* ssq, int unit, int par, int dvg, int lane) {
    const int r = lane & 31, h = lane >> 5, l = 32 * LB + r;
    const int bh = unit >> 6, j = unit & 63, b = bh >> 3, hh = bh & 7, t0 = 64 * j;
    const size_t tok = (size_t)b * SEQ + t0 + l;
    const float cml = misc[MI_CM + (size_t)bh * SEQ + t0 + l], bbl = misc[MI_BB + (size_t)bh * SEQ + t0 + l], mst = misc[MI_MS + bh * 64 + j];
    const float* AAp = misc + MI_AA + (size_t)bh * SEQ + t0 + 4 * h;
    const float* njp = misc + MI_NJ + ((size_t)bh * 64 + j) * 128 + 8 * h;
    bf16x8 qf[8], kf[LB + 1][8];
#pragma unroll
    for (int ks = 0; ks < 8; ++ks) qf[ks] = *(const bf16x8*)(Q + ((size_t)(unit * 2 + LB) * 8 + ks) * 512 + lane * 8);
#pragma unroll
    for (int sb = 0; sb <= LB; ++sb) {
#pragma unroll
        for (int ks = 0; ks < 8; ++ks) kf[sb][ks] = *(const bf16x8*)(Kr + ((size_t)(unit * 2 + sb) * 8 + ks) * 512 + lane * 8);
    }
    f32x4 a4[LB + 1][4];
#pragma unroll
    for (int sb = 0; sb <= LB; ++sb)
#pragma unroll
        for (int q = 0; q < 4; ++q) a4[sb][q] = *(const f32x4*)(AAp + 32 * sb + 8 * q);
    asm volatile("" ::: "memory");
    const float Ml = fmaxf(mst, cml), el = -bbl - Ml, winter = __expf(mst - Ml);
    f32x16 s[LB + 1];
#pragma unroll
    for (int sb = 0; sb <= LB; ++sb) {
#pragma unroll
        for (int i = 0; i < 16; ++i) s[sb][i] = 0.f;
#pragma unroll
        for (int ks = 0; ks < 8; ++ks) s[sb] = mfma32(kf[sb][ks], qf[ks], s[sb]);
    }
    u32x4 va[LB + 1][2][2];
#pragma unroll
    for (int sb = 0; sb <= LB; ++sb)
#pragma unroll
        for (int sp = 0; sp < 2; ++sp)
#pragma unroll
            for (int db = 0; db < 2; ++db) va[sb][sp][db] = *(const u32x4*)(VT + (((size_t)unit * 8 + 2 * dvg + db) * 4 + 2 * sb + sp) * 512 + lane * 8);
    bf16x8 cf[2][8];
#pragma unroll
    for (int ks = 0; ks < 8; ++ks) { cf[0][ks] = *(const bf16x8*)(CT + (((size_t)unit * 8 + 2 * dvg) * 8 + ks) * 512 + lane * 8); cf[1][ks] = *(const bf16x8*)(CT + (((size_t)unit * 8 + 2 * dvg + 1) * 8 + ks) * 512 + lane * 8); }
    asm volatile("" ::: "memory");
    f32x16 o0, o1;
#pragma unroll
    for (int i = 0; i < 16; ++i) { o0[i] = 0.f; o1[i] = 0.f; }
    float den = 0.f;
#pragma unroll
    for (int sb = 0; sb <= LB; ++sb) {
        float pv[16];
#pragma unroll
        for (int q = 0; q < 4; ++q)
#pragma unroll
            for (int e = 0; e < 4; ++e) {
                const int srow = 32 * sb + 8 * q + 4 * h + e;
                const float d = (sb < LB || srow <= l) ? __expf(a4[sb][q][e] - Ml) : 0.f;
                const float p = s[sb][4 * q + e] * d; pv[4 * q + e] = p; den += p;
            }
#pragma unroll
        for (int sp = 0; sp < 2; ++sp) {
            u32x4 pb; pb.x = pk_bf16(pv[8 * sp], pv[8 * sp + 1]); pb.y = pk_bf16(pv[8 * sp + 2], pv[8 * sp + 3]); pb.z = pk_bf16(pv[8 * sp + 4], pv[8 * sp + 5]); pb.w = pk_bf16(pv[8 * sp + 6], pv[8 * sp + 7]);
            const bf16x8 bfr = __builtin_bit_cast(bf16x8, pb);
            o0 = mfma32(__builtin_bit_cast(bf16x8, va[sb][sp][0]), bfr, o0);
            o1 = mfma32(__builtin_bit_cast(bf16x8, va[sb][sp][1]), bfr, o1);
        }
    }
    const size_t gzo = (((size_t)(unit * 2 + LB) * 32 + 8 * dvg) * 64 + lane) * 4;
    u32x2 og[2][4], za[2][4];
#pragma unroll
    for (int db = 0; db < 2; ++db)
#pragma unroll
        for (int q = 0; q < 4; ++q) { og[db][q] = *(const u32x2*)(OG + gzo + (4 * db + q) * 256); za[db][q] = *(const u32x2*)(ZA + gzo + (4 * db + q) * 256); }
    asm volatile("" ::: "memory");
    float deni = 0.f;
#pragma unroll
    for (int ks = 0; ks < 8; ++ks) {
        const u32x4 qr = __builtin_bit_cast(u32x4, qf[ks]);
        const float q0 = bf_lo(qr.x) * winter, q1 = bf_hi(qr.x) * winter, q2 = bf_lo(qr.y) * winter, q3 = bf_hi(qr.y) * winter;
        const float q4 = bf_lo(qr.z) * winter, q5 = bf_hi(qr.z) * winter, q6 = bf_lo(qr.w) * winter, q7 = bf_hi(qr.w) * winter;
        const f32x4 n0 = *(const f32x4*)(njp + 16 * ks), n1 = *(const f32x4*)(njp + 16 * ks + 4);
        deni += (q0 * n0[0] + q1 * n0[1]) + (q2 * n0[2] + q3 * n0[3]) + (q4 * n1[0] + q5 * n1[1]) + (q6 * n1[2] + q7 * n1[3]);
        u32x4 qs; qs.x = pk_bf16(q0, q1); qs.y = pk_bf16(q2, q3); qs.z = pk_bf16(q4, q5); qs.w = pk_bf16(q6, q7);
        const bf16x8 qb = __builtin_bit_cast(bf16x8, qs);
        o0 = mfma32(cf[0][ks], qb, o0);
        o1 = mfma32(cf[1][ks], qb, o1);
    }
    float dtot = den + deni; dtot += __shfl_xor(dtot, 32);
    const float inv = 1.f / fmaxf(fabsf(dtot), __expf(el));
    float hg[32]; float ss = 0.f;
#pragma unroll
    for (int q = 0; q < 4; ++q) {
        hg[4 * q + 0] = o0[4 * q + 0] * inv * bf_lo(og[0][q].x); hg[4 * q + 1] = o0[4 * q + 1] * inv * bf_hi(og[0][q].x); hg[4 * q + 2] = o0[4 * q + 2] * inv * bf_lo(og[0][q].y); hg[4 * q + 3] = o0[4 * q + 3] * inv * bf_hi(og[0][q].y);
        hg[16 + 4 * q + 0] = o1[4 * q + 0] * inv * bf_lo(og[1][q].x); hg[16 + 4 * q + 1] = o1[4 * q + 1] * inv * bf_hi(og[1][q].x); hg[16 + 4 * q + 2] = o1[4 * q + 2] * inv * bf_lo(og[1][q].y); hg[16 + 4 * q + 3] = o1[4 * q + 3] * inv * bf_hi(og[1][q].y);
    }
#pragma unroll
    for (int i = 0; i < 32; ++i) ss += hg[i] * hg[i];
    ss += __shfl_xor(ss, 32);
    if (h == 0) ssq[(par * 4 + dvg) * 64 + l] = ss;
    const float* hwp = hnw + hh * 256 + 64 * dvg + 4 * h;
    f32x4 hwv[2][4];
#pragma unroll
    for (int db = 0; db < 2; ++db)
#pragma unroll
        for (int q = 0; q < 4; ++q) hwv[db][q] = *(const f32x4*)(hwp + 32 * db + 8 * q);
    __syncthreads();
    const float tot = (ssq[(par * 4 + 0) * 64 + l] + ssq[(par * 4 + 1) * 64 + l]) + (ssq[(par * 4 + 2) * 64 + l] + ssq[(par * 4 + 3) * 64 + l]);
    const float rstd = rsqrtf(tot * (1.f / DV) + EPS);
    LAS unsigned char* patch = (LAS unsigned char*)ssq + 4096 + (dvg * 2 + LB) * 4608;
#pragma unroll
    for (int q = 0; q < 4; ++q) {
#pragma unroll
        for (int db = 0; db < 2; ++db) {
            const u32x2 z = za[db][q]; const f32x4 hw = hwv[db][q];
            const float v0 = hg[16 * db + 4 * q + 0] * rstd * hw[0] * bf_lo(z.x), v1 = hg[16 * db + 4 * q + 1] * rstd * hw[1] * bf_hi(z.x);
            const float v2 = hg[16 * db + 4 * q + 2] * rstd * hw[2] * bf_lo(z.y), v3 = hg[16 * db + 4 * q + 3] * rstd * hw[3] * bf_hi(z.y);
            u32x2 w; w.x = pk_bf16(v0, v1); w.y = pk_bf16(v2, v3);
            *(LAS u32x2*)(patch + r * 144 + (32 * db + 8 * q + 4 * h) * 2) = w;
        }
    }
    asm volatile("s_waitcnt lgkmcnt(0)" ::: "memory");
    bf16_t* hap = HA + pg8::ktm((size_t)b * SEQ + t0 + 32 * LB, hh * 256 + 64 * dvg, 64) + lane * 8;
#pragma unroll
    for (int i = 0; i < 4; ++i) {
        const u32x4 w = *(const LAS u32x4*)(patch + (8 * i + (lane >> 3)) * 144 + (lane & 7) * 16);
        *(u32x4*)(hap + i * 512) = w;
    }
}

__device__ __forceinline__ void p4_mlstm_out(const Args& a, LAS unsigned char* lds, int tid, int lane, int wave, int vcu, int G) {
    unsigned char* ws = a.ws;
    const bf16_t* Q = (const bf16_t*)(ws + WS_Q); const bf16_t* Kr = (const bf16_t*)(ws + WS_K); const bf16_t* VT = (const bf16_t*)(ws + WS_VT);
    const bf16_t* CT = (const bf16_t*)(ws + WS_CT); const bf16_t* OG = (const bf16_t*)(ws + WS_OG); const bf16_t* ZA = (const bf16_t*)(ws + WS_ZA);
    bf16_t* HA = (bf16_t*)(ws + WS_HAB);
    const float* misc = (const float*)(ws + WS_MISC); const float* hnw = a.in[8];
    LAS float* ssq = (LAS float*)lds;
    const int lb = wave & 1, dvg = wave >> 1;
    int par = 0;
    for (int unit = vcu; unit < 32 * NCH; unit += G, par ^= 1) {
        if (lb == 0) p4_unit<0>(Q, Kr, VT, CT, OG, ZA, HA, misc, hnw, ssq, unit, par, dvg, lane);
        else p4_unit<1>(Q, Kr, VT, CT, OG, ZA, HA, misc, hnw, ssq, unit, par, dvg, lane);
    }
}

constexpr int N_PHASES = 7;
__global__ void __launch_bounds__(NWAVES * 64, 2) fwd_kernel(Args args) {
    extern __shared__ __attribute__((aligned(16))) unsigned char lds_raw[];
    LAS unsigned char* lds = (LAS unsigned char*)lds_raw;
    const int tid = threadIdx.x, lane = tid & 63, wave = __builtin_amdgcn_readfirstlane(tid >> 6);
    const int G = gridDim.x; const int bx = blockIdx.x; const int vcu = (G % 8 == 0) ? (bx % 8) * (G / 8) + bx / 8 : bx;
    unsigned char* ws = args.ws;
    volatile LAS unsigned* bst = (volatile LAS unsigned*)(lds + LDS_BYTES - 64);
    if (tid < 16) bst[tid] = 0u;
    __syncthreads();
    XcdBarrier bar; bar.bar = (unsigned*)(ws + WS_CTL) + CW_BAR + args.li * XCD_BAR_WORDS; bar.x = 0; bar.st = nullptr;
    const int lo = args.ph_lo, hi = args.ph_hi;
    if (hi - lo > 1) bar = xcd_barrier_post((unsigned*)(ws + WS_CTL) + CW_BAR + args.li * XCD_BAR_WORDS, bst);
#ifndef PH_MASK
#define PH_MASK 0x7f
#endif
#define IN(k) (((PH_MASK >> (k)) & 1) && lo <= (k) && (k) < hi)
#define SEAM(k) do { if (IN(k) && IN((k) + 1)) xcd_barrier(bar); } while (0)
    if (IN(0)) { p0_prep(args, lds, tid, lane, wave, vcu, G); } SEAM(0);
    if (IN(1)) { p1_hnorm(args, lds, tid, lane, wave, G); } SEAM(1);
    if (IN(2)) {
        pg8::Gemm g{(const bf16_t*)(ws + WS_H), (const bf16_t*)(ws + WS_WINT), MTOK, NPRJ, DM, DM, 64, 0, 0, 128, 256 * DM * 2, 0, 32768, 32 * 32768};
        pg8::StaticOrder S; S.init(MTOK, NPRJ, G, bx);
        pg8::EpiInProj E{(bf16_t*)(ws + WS_Q), (bf16_t*)(ws + WS_K), (bf16_t*)(ws + WS_KT), (bf16_t*)(ws + WS_VT), (bf16_t*)(ws + WS_OG), (bf16_t*)(ws + WS_ZA),
                         (bf16_t*)(ws + WS_HAB), (bf16_t*)args.out, (bf16_t*)args.out + (size_t)MTOK * DM,
                         (const float*)(ws + WS_MISC) + MI_BPERM, args.in[7], (float*)(ws + WS_SB), 4096, lds + 131072};
        pg8::gemm_phase<pg8::EpiInProj, true, true>(lds, g, S, E);
    } SEAM(2);
    if (IN(3)) { p3_scan(args, lds, tid, lane, wave, vcu, G); } SEAM(3);
    if (IN(4)) { p4_mlstm_out(args, lds, tid, lane, wave, vcu, G); } SEAM(4);
    if (IN(5)) {
        pg8::Gemm g{(const bf16_t*)(ws + WS_HAB), (const bf16_t*)(ws + WS_WAB), MTOK, DM, DM, 64, 64, 32 * 32768, 0, 32768, 64 * 32768, 32 * 32768, 32768, 64 * 32768};
        pg8::MergeOrder S; S.so.init(MTOK, DM, G, bx);
        pg8::EpiMerge E{(const bf16_t*)args.out, (const bf16_t*)args.out + (size_t)MTOK * DM, (bf16_t*)(ws + WS_MG)};
        pg8::gemm_phase<pg8::EpiMerge, true, true, pg8::MergeOrder>(lds, g, S, E);
    } SEAM(5);
    if (IN(6)) {
        pg8::Gemm g{(const bf16_t*)(ws + WS_MG), (const bf16_t*)(ws + WS_WOS), MTOK, DM, DM, 64, 64, 0, DM * DM * 2, 32768, 32 * 32768, 0, 32768, 32 * 32768};
        pg8::PanelOrder S{vcu};
        pg8::EpiOutNorm E{args.in[0], (const float*)(ws + WS_CTL) + CW_MOD + 4096, args.in[12], args.out, (float*)(ws + WS_CTL) + CW_ROWSS, (unsigned*)(ws + WS_CTL) + CW_CNT};
        pg8::gemm_phase<pg8::EpiOutNorm, true, true, pg8::PanelOrder>(lds, g, S, E);
    }
#undef IN
#undef SEAM
}

extern "C" void kernel_launch(void* const* d_in, const int* in_sizes, int n_in, void* d_out, int out_size, void* d_ws, size_t ws_size, hipStream_t stream) {
    static int grid = 0;
    if (grid == 0) {
        if (n_in != 13 || out_size != MTOK * DM || ws_size < WS_END) { fprintf(stderr, "kernel_launch: unexpected problem (n_in %d, out %d, ws %zu)\n", n_in, out_size, ws_size); grid = -1; return; }
        int dev = 0, cus = 0, per_cu = 0;
        if (hipGetDevice(&dev) != hipSuccess || hipDeviceGetAttribute(&cus, hipDeviceAttributeMultiprocessorCount, dev) != hipSuccess) { grid = -1; return; }
        if (hipFuncSetAttribute((const void*)fwd_kernel, hipFuncAttributeMaxDynamicSharedMemorySize, LDS_BYTES) != hipSuccess) { fprintf(stderr, "kernel_launch: hipFuncSetAttribute failed\n"); grid = -1; return; }
        if (hipOccupancyMaxActiveBlocksPerMultiprocessor(&per_cu, (const void*)fwd_kernel, NWAVES * 64, LDS_BYTES) != hipSuccess || per_cu < 1) { fprintf(stderr, "kernel_launch: occupancy query says %d blocks per CU\n", per_cu); }
        (void)hipGetLastError();
        grid = cus;
        if (grid != 256) fprintf(stderr, "kernel_launch: %d CUs; the phase program is laid out for 256\n", grid);
    }
    if (grid < 0) return;
    (void)hipMemsetAsync((char*)d_ws + WS_CTL, 0, CTL_ZERO_BYTES, stream);
    Args a{};
    for (int i = 0; i < 13; ++i) a.in[i] = (const float*)d_in[i];
    a.out = (float*)d_out; a.ws = (unsigned char*)d_ws;
#ifdef PROF_SEQ
    if (true) {
        const int seq[][2] = PROF_SEQ;
        for (unsigned i = 0; i < sizeof(seq) / sizeof(seq[0]); ++i) { a.ph_lo = seq[i][0]; a.ph_hi = seq[i][1]; a.li = i; hipLaunchKernelGGL(fwd_kernel, dim3(grid), dim3(NWAVES * 64), LDS_BYTES, stream, a); }
    } else
#endif
    if (MK_N_LAUNCHES == 1) {
        a.ph_lo = 0; a.ph_hi = N_PHASES; a.li = 0;
        hipLaunchKernelGGL(fwd_kernel, dim3(grid), dim3(NWAVES * 64), LDS_BYTES, stream, a);
    } else {
        for (int p = 0; p < N_PHASES; ++p) { a.ph_lo = p; a.ph_hi = p + 1; a.li = p; hipLaunchKernelGGL(fwd_kernel, dim3(grid), dim3(NWAVES * 64), LDS_BYTES, stream, a); }
    }
}
```

```cpp
#include <hip/hip_runtime.h>
#include <cstdio>
#include <cstdint>

#ifndef MK_N_LAUNCHES
#define MK_N_LAUNCHES 1
#endif

#define LAS __attribute__((address_space(3)))
typedef unsigned short bf16_t;
typedef short bf16x8 __attribute__((ext_vector_type(8)));
typedef short s16x4 __attribute__((ext_vector_type(4)));
typedef float f32x2 __attribute__((ext_vector_type(2)));
typedef float f32x4 __attribute__((ext_vector_type(4)));
typedef float f32x16 __attribute__((ext_vector_type(16)));
typedef unsigned u32x2 __attribute__((ext_vector_type(2)));
typedef unsigned u32x4 __attribute__((ext_vector_type(4)));
#ifndef USE_FP16
#define USE_FP16 0
#endif
#if USE_FP16
typedef _Float16 h2_t __attribute__((ext_vector_type(2)));
typedef _Float16 h8_t __attribute__((ext_vector_type(8)));
#define ONES16 0x3c003c00u
#define MFMA16(a, b, c) __builtin_amdgcn_mfma_f32_16x16x32_f16(__builtin_bit_cast(h8_t, a), __builtin_bit_cast(h8_t, b), c, 0, 0, 0)
#define MFMA32(a, b, c) __builtin_amdgcn_mfma_f32_32x32x16_f16(__builtin_bit_cast(h8_t, a), __builtin_bit_cast(h8_t, b), c, 0, 0, 0)
#else
typedef __bf16 h2_t __attribute__((ext_vector_type(2)));
#define ONES16 0x3f803f80u
#define MFMA16(a, b, c) __builtin_amdgcn_mfma_f32_16x16x32_bf16(a, b, c, 0, 0, 0)
#define MFMA32(a, b, c) __builtin_amdgcn_mfma_f32_32x32x16_bf16(a, b, c, 0, 0, 0)
#endif

constexpr int NB = 4, SEQ = 4096, DM = 2048, MTOK = NB * SEQ;
constexpr int NH = 8, DK = 128, DV = 256, CH = 64, NCH = SEQ / CH;
constexpr int INW = 20496, NPRJ = 20480;
constexpr int O_IF = 8192;
constexpr float EPS = 1e-6f;

__device__ __forceinline__ unsigned pk_bf16(float lo, float hi) { f32x2 v = {lo, hi}; h2_t b = __builtin_convertvector(v, h2_t); return __builtin_bit_cast(unsigned, b); }
#if USE_FP16
__device__ __forceinline__ float bf_lo(unsigned u) { return (float)__builtin_bit_cast(h2_t, u)[0]; }
__device__ __forceinline__ float bf_hi(unsigned u) { return (float)__builtin_bit_cast(h2_t, u)[1]; }
#else
__device__ __forceinline__ float bf_lo(unsigned u) { return __uint_as_float(u << 16); }
__device__ __forceinline__ float bf_hi(unsigned u) { return __uint_as_float(u & 0xffff0000u); }
#endif
__device__ __forceinline__ float sigmoid_f(float x) { return __builtin_amdgcn_rcpf(1.f + __builtin_amdgcn_exp2f(x * -1.4426950408889634f)); }
__device__ __forceinline__ float silu_f(float x) { return x * sigmoid_f(x); }
__device__ __forceinline__ float silu_acc(float x) { return x / (1.f + expf(-x)); }
__device__ __forceinline__ float wave_sum(float v) {
#pragma unroll
    for (int o = 1; o < 64; o <<= 1) v += __shfl_xor(v, o);
    return v;
}

__device__ __forceinline__ int win_src_col(int np) {
    const int pn = np >> 8, jc = np & 255;
    if (pn < 32) return np;
    if (pn < 64) {
        const int c = pn - 32, bj = jc >> 7, wc = (jc >> 5) & 3, fq = (jc >> 3) & 3, n = (jc >> 2) & 1, e = jc & 3;
        return 8208 + 2048 * (2 * bj + n) + 64 * c + 16 * wc + 4 * fq + e;
    }
    return ((jc >> 7) ? 18448 : 16400) + 128 * (pn - 64) + (jc & 127);
}

namespace pg8 {
constexpr int BM = 256, BK = 64, HALF = 128, HTB = HALF * BK * 2, STAGE_BYTES = 8 * HTB, NXCD = 8, WGM = 8;
__host__ __device__ __forceinline__ int lds_byte(int r, int c) { const int st = (r >> 4) * 2 + (c >> 5), rr = r & 15, cc = c & 31, ob = rr * 64 + cc * 2; return st * 1024 + (ob ^ (((ob >> 9) & 1) << 5)); }
__host__ __device__ __forceinline__ void stage_rc(int b, int& R, int& C) { const int st = b / 1024, sb = b % 1024, swz = sb ^ (((sb >> 9) & 1) << 5); R = (st >> 1) * 16 + swz / 64; C = (st & 1) * 32 + (swz % 64) / 2; }
__host__ __device__ __forceinline__ int perm32(int rho) { const int n = rho >> 4, i = rho & 15; return 8 * (i >> 2) + 4 * n + (i & 3); }

__device__ __forceinline__ float ror8(float x) { return __int_as_float(__builtin_amdgcn_update_dpp(0, __float_as_int(x), 0x128, 0xf, 0xf, false)); }
__device__ __forceinline__ f32x4 ror8(f32x4 v) { return (f32x4){ror8(v[0]), ror8(v[1]), ror8(v[2]), ror8(v[3])}; }
__host__ __device__ __forceinline__ size_t ktm(size_t row, int col, int nkt) { return (row >> 8) * ((size_t)nkt * 16384) + (size_t)(col >> 6) * 16384 + (row & 255) * 64 + (size_t)(col & 63); }
struct Unit { int pm, pn, which, par; };
struct Gemm { const bf16_t* A; const bf16_t* Bt; int M, N, K, lda, ldb, koff, bb, ksA, tsA, koffA, ksB, tsB; };

struct StaticOrder {
    int nM, nN, nwg, G, c;
    __device__ void init(int M, int N, int G_, int c_) { nM = M / BM; nN = N / BM; nwg = nM * nN; G = G_; c = c_; }
    __device__ bool next(int i, Unit& u) const {
        const long L = (long)i * G + c; if (L >= nwg) return false;
        int wgid = (int)L; { const int q = nwg / NXCD, r = nwg % NXCD, xcd = wgid % NXCD, off = wgid / NXCD; wgid = (xcd < r ? xcd * (q + 1) : r * (q + 1) + (xcd - r) * q) + off; }
        const int nig = WGM * nN, gid = wgid / nig, fm = gid * WGM, gsz = (nM - fm) < WGM ? (nM - fm) : WGM;
        u.pm = fm + ((wgid % nig) % gsz); u.pn = (wgid % nig) / gsz; u.which = 0; return true;
    }
};

template <class Epi, bool ALIGN_EPI, bool SP2, class Sched = StaticOrder>
__device__ __forceinline__ void gemm_phase(LAS unsigned char* lds, const Gemm g, const Sched& S, const Epi& E) {
    const int tid = threadIdx.x, wid = __builtin_amdgcn_readfirstlane(tid >> 6), lane = tid & 63, wr = wid >> 2, wc = wid & 3, fr = lane & 15, fq = lane >> 4;
    const int K = g.K, nt = K / BK;
    unsigned voffA[2], voffB[2];
#pragma unroll
    for (int i = 0; i < 2; ++i) { int R, C; stage_rc(tid * 16 + i * 8192, R, C); const int Rb = Epi::PERM ? ((R & ~31) + perm32(R & 31)) : R;
        voffA[i] = (unsigned)(R * g.lda + C) * 2u; voffB[i] = (unsigned)(Rb * g.ldb + C) * 2u; }
    const size_t kstep = (size_t)g.ksB;
    const size_t hstepA = (size_t)HALF * g.lda * 2, hstepB = (size_t)HALF * g.ldb * 2;
    const size_t tstepA = (size_t)g.tsA, tstepB = (size_t)g.tsB, kstepA = (size_t)g.ksA;
    const unsigned ldsw = (unsigned)wid * 1024u;
    const int aoff = lds_byte(wr * 64 + fr, fq * 8), boff = lds_byte(wc * 32 + fr, fq * 8);
#define PG8_SA(b, h) (((b) * 2 + (h)) * HTB)
#define PG8_SB(b, h) ((4 + (b) * 2 + (h)) * HTB)
#define PG8_STAGE(bufoff, gbase, voff) do { const char* _gb = (const char*)(gbase); if constexpr (Epi::KHOOK) asm volatile("" : "+s"(_gb)); _Pragma("unroll") for (int _i = 0; _i < 2; ++_i) \
        __builtin_amdgcn_global_load_lds((const unsigned*)(_gb + (voff)[_i]), (LAS unsigned*)(lds + (bufoff) + ldsw + _i * 8192), 16, 0, 0); } while (0)
#define PG8_LDA(dst, b, h) do { _Pragma("unroll") for (int m = 0; m < 4; ++m) _Pragma("unroll") for (int k = 0; k < 2; ++k) dst[m][k] = *(const LAS bf16x8*)(lds + PG8_SA(b, h) + aoff + m * 2048 + k * 1024); } while (0)
#define PG8_LDB(dst, b, h) do { _Pragma("unroll") for (int n = 0; n < 2; ++n) _Pragma("unroll") for (int k = 0; k < 2; ++k) dst[n][k] = *(const LAS bf16x8*)(lds + PG8_SB(b, h) + boff + n * 2048 + k * 1024); } while (0)
#define PG8_MMA(ai, bj, At, Bt) do { __builtin_amdgcn_s_setprio(1); _Pragma("unroll") for (int m = 0; m < 4; ++m) _Pragma("unroll") for (int n = 0; n < 2; ++n) _Pragma("unroll") for (int k = 0; k < 2; ++k) \
        acc[ai][bj][m][n] = MFMA16(Bt[n][k], At[m][k], acc[ai][bj][m][n]); __builtin_amdgcn_s_setprio(0); } while (0)
#define PG8_WAIT_V(n) asm volatile("s_waitcnt vmcnt(" #n ")" ::: "memory")
#define PG8_WAIT_L(n) asm volatile("s_waitcnt lgkmcnt(" #n ")" ::: "memory")
#define PG8_BAR __builtin_amdgcn_s_barrier()
#define PG8_SCHED __builtin_amdgcn_sched_barrier(0)
    Unit cur, nxt; int ui = 0;
    if (!S.next(0, cur)) return;
    cur.par = 0;
    f32x4 acc[2][2][4][2];
#pragma unroll
    for (int a = 0; a < 2; ++a)
#pragma unroll
        for (int b = 0; b < 2; ++b)
#pragma unroll
            for (int m = 0; m < 4; ++m)
#pragma unroll
                for (int n = 0; n < 2; ++n) acc[a][b][m][n] = (f32x4){0.f, 0.f, 0.f, 0.f};
    bf16x8 At[4][2], B0[2][2], B1[2][2];
    const char* cA = (const char*)g.A + (size_t)cur.pm * tstepA + (size_t)cur.which * g.koffA; const char* cB = (const char*)g.Bt + (size_t)cur.pn * tstepB + (size_t)cur.which * g.koff + (size_t)(cur.pm >> 4) * g.bb;
    const float* hkb = nullptr; unsigned hkoffA = 0, hkoffB = 0; f32x4 hx0, hx1;
    if constexpr (Epi::KHOOK) {
        hkb = E.hook_base(cur);
        hkoffA = (unsigned)(((wr * 64 + (fr & 7)) * g.N + wc * 32 + 4 * fq + (fr < 8 ? 0 : 16)) * 4); hkoffB = (unsigned)(((wr * 64 + 8 + (fr & 7)) * g.N + wc * 32 + 4 * fq + (fr < 8 ? 16 : 0)) * 4);
    }
    if constexpr (Epi::LDS_CONST) { if (wid == 0) E.stage_consts(cur, lds, lane); }
    if constexpr (SP2) {
        PG8_STAGE(PG8_SB(0, 0), cB, voffB); PG8_STAGE(PG8_SB(0, 1), cB + hstepB, voffB); PG8_STAGE(PG8_SA(0, 0), cA, voffA); PG8_STAGE(PG8_SA(0, 1), cA + hstepA, voffA);
        if (wr == 1) PG8_BAR;
        PG8_WAIT_V(2); PG8_BAR;
        PG8_STAGE(PG8_SB(1, 0), cB + kstep, voffB); PG8_STAGE(PG8_SA(1, 0), cA + kstepA, voffA); PG8_STAGE(PG8_SB(1, 1), cB + hstepB + kstep, voffB);
        PG8_WAIT_V(6); PG8_BAR;
    } else {
        PG8_STAGE(PG8_SB(0, 0), cB, voffB); PG8_STAGE(PG8_SA(0, 0), cA, voffA); PG8_STAGE(PG8_SB(0, 1), cB + hstepB, voffB); PG8_STAGE(PG8_SA(0, 1), cA + hstepA, voffA);
        if (wr == 1) PG8_BAR;
        PG8_WAIT_V(4); PG8_BAR;
        PG8_STAGE(PG8_SB(1, 0), cB + kstep, voffB); PG8_STAGE(PG8_SA(1, 0), cA + kstepA, voffA); PG8_STAGE(PG8_SB(1, 1), cB + hstepB + kstep, voffB);
        PG8_WAIT_V(6); PG8_BAR;
    }
    for (;;) {
        const bool has_next = S.next(ui + 1, nxt); nxt.par = (ui + 1) & 1;
        const char* nA = has_next ? (const char*)g.A + (size_t)nxt.pm * tstepA + (size_t)nxt.which * g.koffA : cA; const char* nB = has_next ? (const char*)g.Bt + (size_t)nxt.pn * tstepB + (size_t)nxt.which * g.koff + (size_t)(nxt.pm >> 4) * g.bb : cB;
        for (int t0 = 0; t0 < nt; t0 += (Epi::KHOOK ? 8 : 2)) {
#pragma unroll
          for (int hu = 0; hu < (Epi::KHOOK ? 4 : 1); ++hu) {
            const int t = t0 + 2 * hu;
            const bool last = (t == nt - 2);
            const char* a1 = cA + (size_t)(t + 1) * kstepA;
            const char* a2 = last ? nA : cA + (size_t)(t + 2) * kstepA; const char* b2 = last ? nB : cB + (size_t)(t + 2) * kstep;
            const char* a3 = a2 + kstepA; const char* b3 = b2 + kstep;
            if constexpr (SP2) {
            PG8_LDB(B0, 0, 0); PG8_LDB(B1, 0, 1); PG8_SCHED; PG8_LDA(At, 0, 0); PG8_STAGE(PG8_SA(1, 1), a1 + hstepA, voffA);
            if constexpr (Epi::KHOOK) {
                const int hq = t0 >> 3; const float* hp = hkb + (size_t)((hq >> 1) * HALF + hu * 16) * g.N + (hq & 1) * HALF;
                asm volatile("global_load_dwordx4 %0, %1, %2" : "=&v"(hx0) : "v"(hkoffA), "s"(hp) : "memory");
                asm volatile("global_load_dwordx4 %0, %1, %2" : "=&v"(hx1) : "v"(hkoffB), "s"(hp) : "memory");
                PG8_WAIT_V(10);
            } else { PG8_WAIT_V(8); }
            PG8_WAIT_L(0); PG8_BAR; PG8_MMA(0, 0, At, B0); PG8_MMA(0, 1, At, B1); PG8_BAR; PG8_SCHED;
            PG8_LDA(At, 0, 1); PG8_STAGE(PG8_SB(0, 0), b2, voffB); PG8_STAGE(PG8_SB(0, 1), b2 + hstepB, voffB); PG8_STAGE(PG8_SA(0, 0), a2, voffA);
            if constexpr (Epi::KHOOK) { PG8_WAIT_V(10); } else { PG8_WAIT_V(8); }
            PG8_WAIT_L(0); PG8_BAR; PG8_MMA(1, 0, At, B0); PG8_MMA(1, 1, At, B1); PG8_BAR; PG8_SCHED;
            PG8_LDB(B0, 1, 0); PG8_LDB(B1, 1, 1); PG8_SCHED; PG8_LDA(At, 1, 0); PG8_STAGE(PG8_SA(0, 1), a2 + hstepA, voffA);
            PG8_WAIT_V(8); PG8_WAIT_L(0); PG8_BAR; PG8_MMA(0, 0, At, B0); PG8_MMA(0, 1, At, B1); PG8_BAR; PG8_SCHED;
            if constexpr (Epi::KHOOK) {
                const int hq = t0 >> 3;
                const bool lo8 = fr < 8;
                f32x4 own0, oth;
#pragma unroll
                for (int e = 0; e < 4; ++e) { own0[e] = lo8 ? hx0[e] : hx1[e]; oth[e] = lo8 ? hx1[e] : hx0[e]; }
                const f32x4 own1 = ror8(oth);
#pragma unroll
                for (int q = 0; q < 4; ++q) { const float sel = (hq == q) ? 1.f : 0.f;
                    acc[q >> 1][q & 1][hu][0] += own0 * sel; acc[q >> 1][q & 1][hu][1] += own1 * sel; }
                PG8_SCHED;
            }
            PG8_LDA(At, 1, 1); PG8_STAGE(PG8_SB(1, 0), b3, voffB); PG8_STAGE(PG8_SB(1, 1), b3 + hstepB, voffB); PG8_STAGE(PG8_SA(1, 0), a3, voffA);
            PG8_WAIT_V(8); PG8_WAIT_L(0); PG8_BAR; PG8_MMA(1, 0, At, B0); PG8_MMA(1, 1, At, B1); PG8_BAR; PG8_SCHED;
            } else {
            PG8_LDB(B0, 0, 0); PG8_SCHED; PG8_LDA(At, 0, 0); PG8_STAGE(PG8_SA(1, 1), a1 + hstepA, voffA);
            PG8_WAIT_L(8); PG8_BAR; PG8_WAIT_L(0); PG8_MMA(0, 0, At, B0); PG8_BAR; PG8_SCHED;
            PG8_LDB(B1, 0, 1); PG8_STAGE(PG8_SB(0, 0), b2, voffB);
            PG8_BAR; PG8_WAIT_L(0); PG8_MMA(0, 1, At, B1); PG8_BAR;
            PG8_LDA(At, 0, 1); PG8_STAGE(PG8_SA(0, 0), a2, voffA);
            PG8_BAR; PG8_WAIT_L(0); PG8_MMA(1, 0, At, B0); PG8_BAR; PG8_SCHED;
            PG8_STAGE(PG8_SB(0, 1), b2 + hstepB, voffB);
            PG8_WAIT_V(6); PG8_BAR; PG8_MMA(1, 1, At, B1); PG8_BAR;
            PG8_LDB(B0, 1, 0); PG8_SCHED; PG8_LDA(At, 1, 0); PG8_STAGE(PG8_SA(0, 1), a2 + hstepA, voffA);
            PG8_WAIT_L(8); PG8_BAR; PG8_WAIT_L(0); PG8_MMA(0, 0, At, B0); PG8_BAR; PG8_SCHED;
            PG8_LDB(B1, 1, 1); PG8_STAGE(PG8_SB(1, 0), b3, voffB);
            PG8_BAR; PG8_WAIT_L(0); PG8_MMA(0, 1, At, B1); PG8_BAR;
            PG8_LDA(At, 1, 1); PG8_STAGE(PG8_SA(1, 0), a3, voffA);
            PG8_BAR; PG8_WAIT_L(0); PG8_MMA(1, 0, At, B0); PG8_BAR; PG8_SCHED;
            PG8_STAGE(PG8_SB(1, 1), b3 + hstepB, voffB);
            PG8_WAIT_V(6); PG8_BAR; PG8_MMA(1, 1, At, B1); PG8_BAR;
            }
          }
        }
        if constexpr (ALIGN_EPI) { if (wr == 0) PG8_BAR; }
        E(acc, cur, wr, wc, fr, fq);
        if (!has_next) break;
        if (!Epi::keeps_acc(cur)) {
#pragma unroll
        for (int a = 0; a < 2; ++a)
#pragma unroll
            for (int b = 0; b < 2; ++b)
#pragma unroll
                for (int m = 0; m < 4; ++m)
#pragma unroll
                    for (int n = 0; n < 2; ++n) acc[a][b][m][n] = (f32x4){0.f, 0.f, 0.f, 0.f};
        }
        cur = nxt; cA = nA; cB = nB; ++ui;
        if constexpr (Epi::KHOOK) hkb = E.hook_base(cur);
        if constexpr (Epi::LDS_CONST) { if (wid == 0) E.stage_consts(cur, lds, lane); }
        if constexpr (ALIGN_EPI) { if (wr == 1) PG8_BAR; }
    }
    PG8_WAIT_V(0);
    if constexpr (!ALIGN_EPI) { if (wr == 0) PG8_BAR; }
    PG8_BAR;
#undef PG8_SA
#undef PG8_SB
#undef PG8_STAGE
#undef PG8_LDA
#undef PG8_LDB
#undef PG8_MMA
#undef PG8_WAIT_V
#undef PG8_WAIT_L
#undef PG8_BAR
#undef PG8_SCHED
}


struct EpiInProj {
    static __device__ __forceinline__ bool keeps_acc(const Unit&) { return false; }
    static constexpr bool PERM = true; static constexpr bool LDS_CONST = true; static constexpr bool KHOOK = false;
    bf16_t *Q, *Kr, *KT, *VT, *OG, *ZA, *HB, *GA, *GB; const float* bias; const float* convw; float* SB; int ldhb; LAS unsigned char* tlds;
    __device__ __forceinline__ void stage_consts(const Unit& u, LAS unsigned char* lds, int lane) const {
        LAS unsigned char* cb = tlds + 9216 + 2048 * u.par;
        __builtin_amdgcn_global_load_lds((const unsigned*)(bias + u.pn * BM + 4 * lane), (LAS unsigned*)cb, 16, 0, 0);
        if (u.pn >= 32 && u.pn < 64) {
#pragma unroll
            for (int tap = 0; tap < 3; ++tap) __builtin_amdgcn_global_load_lds((const unsigned*)(convw + tap * 2048 + 64 * (u.pn - 32) + lane), (LAS unsigned*)(cb + 1024 + 256 * tap), 4, 0, 0);
        }
        (void)lds;
    }
    __device__ __forceinline__ void operator()(f32x4 (&acc)[2][2][4][2], const Unit& u, int wr, int wc, int fr, int fq) const {
        const int pn = u.pn;
        const LAS float* cbias = (const LAS float*)(tlds + 9216 + 2048 * u.par) + wc * 32 + 8 * fq;
        const LAS float* ctap = (const LAS float*)(tlds + 9216 + 2048 * u.par + 1024) + 16 * wc + 4 * fq;
        const int row0 = u.pm * BM + wr * 64 + fr;
        const int bcol0 = pn * BM + wc * 32 + 8 * fq;
        if (pn >= 32 && pn < 64) {
            const int ch0 = 64 * (pn - 32) + 16 * wc + 4 * fq;
            const f32x4 w0 = *(const LAS f32x4*)(ctap), w1 = *(const LAS f32x4*)(ctap + 64), w2 = *(const LAS f32x4*)(ctap + 128);
            const f32x4 bu = *(const LAS f32x4*)(cbias), bB = *(const LAS f32x4*)(cbias + 4), bC = *(const LAS f32x4*)(cbias + HALF), bz = *(const LAS f32x4*)(cbias + HALF + 4);
            const int lane = fq * 16 + fr;
#pragma unroll
            for (int ai = 0; ai < 2; ++ai) {
                f32x4 pr1 = (f32x4){0.f, 0.f, 0.f, 0.f}, pr2 = pr1;
                const int g = u.pm * 4 + ai * 2 + wr;
                float* sb = SB + (size_t)g * 6 * 2048 + ch0;
#pragma unroll
                for (int m = 0; m < 4; ++m) {
                    const f32x4 uu = acc[ai][0][m][0] + bu, Bv = acc[ai][0][m][1] + bB, Cv = acc[ai][1][m][0] + bC, zb = acc[ai][1][m][1] + bz;
                    f32x4 cu, bzv, r1, r2, p1, p2, hb;
#pragma unroll
                    for (int e = 0; e < 4; ++e) { cu[e] = Cv[e] * uu[e]; bzv[e] = Bv[e] * silu_f(zb[e]); }
#pragma unroll
                    for (int e = 0; e < 4; ++e) { r1[e] = __int_as_float(__builtin_amdgcn_update_dpp(0, __float_as_int(cu[e]), 0x121, 0xf, 0xf, false)); r2[e] = __int_as_float(__builtin_amdgcn_update_dpp(0, __float_as_int(cu[e]), 0x122, 0xf, 0xf, false)); }
#pragma unroll
                    for (int e = 0; e < 4; ++e) { p1[e] = fr >= 1 ? r1[e] : pr1[e]; p2[e] = fr >= 2 ? r2[e] : pr2[e]; }
                    const f32x4 cv = w0 * p2 + w1 * p1 + w2 * cu;
                    hb = bzv * cv;
                    u32x2 w; w.x = pk_bf16(hb[0], hb[1]); w.y = pk_bf16(hb[2], hb[3]);
                    *(u32x2*)(HB + ktm((size_t)(row0 + ai * HALF + m * 16), 2048 + ch0, 64)) = w;
                    if (m == 0 && fr < 2) { *(f32x4*)(sb + (2 + fr) * 2048) = bzv; *(f32x4*)(sb + (4 + fr) * 2048) = cv; }
                    if (m == 3 && fr >= 14) { *(f32x4*)(sb + (fr - 14) * 2048) = cu; }
                    pr1 = r1; pr2 = r2;
                }
            }
            return;
        }
        int kind, colt, act = 0; float sc = 1.f; bf16_t* dst = nullptr; bf16_t* dstT = nullptr;
        if (pn < 4) { kind = 0; dst = Q; colt = pn * BM; sc = 0.08838834764831845f; }
        else if (pn < 8) { kind = 1; dst = Kr; dstT = KT; colt = (pn - 4) * BM; }
        else if (pn < 16) { kind = 2; dstT = VT; colt = (pn - 8) * BM; }
        else if (pn < 24) { kind = 3; dst = OG; colt = (pn - 16) * BM; act = 1; }
        else if (pn < 32) { kind = 4; dst = ZA; colt = (pn - 24) * BM; act = 2; }
        else {
            const int ch0 = 128 * (pn - 64) + wc * 32 + 8 * fq;
            f32x4 ba[2], bb[2];
#pragma unroll
            for (int n = 0; n < 2; ++n) { ba[n] = *(const LAS f32x4*)(cbias + 4 * n); bb[n] = *(const LAS f32x4*)(cbias + HALF + 4 * n); }
#pragma unroll
            for (int ai = 0; ai < 2; ++ai)
#pragma unroll
                for (int m = 0; m < 4; ++m) {
                    const size_t off = ((((((size_t)(u.pm * 2 + ai) * 2 + wr) * 4 + m) * 16 + (pn - 64)) * 4 + wc) * 64 + fq * 16 + fr) * 8;
                    float rr[8], gg[8];
#pragma unroll
                    for (int n = 0; n < 2; ++n)
#pragma unroll
                        for (int e = 0; e < 4; ++e) {
                            const float ea = __builtin_amdgcn_exp2f((acc[ai][0][m][n][e] + ba[n][e]) * -1.4426950408889634f), eb = __builtin_amdgcn_exp2f((acc[ai][1][m][n][e] + bb[n][e]) * -1.4426950408889634f);
                            rr[4 * n + e] = (1.f + eb) * __builtin_amdgcn_rcpf(1.f + ea); gg[4 * n + e] = __builtin_amdgcn_rcpf(1.f + eb);
                        }
                    u32x4 wr_, wg_;
                    wr_.x = pk_bf16(rr[0], rr[1]); wr_.y = pk_bf16(rr[2], rr[3]); wr_.z = pk_bf16(rr[4], rr[5]); wr_.w = pk_bf16(rr[6], rr[7]);
                    wg_.x = pk_bf16(gg[0], gg[1]); wg_.y = pk_bf16(gg[2], gg[3]); wg_.z = pk_bf16(gg[4], gg[5]); wg_.w = pk_bf16(gg[6], gg[7]);
                    *(u32x4*)(GA + off) = wr_; *(u32x4*)(GB + off) = wg_;
                }
            return;
        }
        const int col0 = colt + wc * 32 + 8 * fq;
        f32x4 bv[2][2];
#pragma unroll
        for (int bj = 0; bj < 2; ++bj)
#pragma unroll
            for (int n = 0; n < 2; ++n) bv[bj][n] = *(const LAS f32x4*)(cbias + bj * HALF + 4 * n);
        if (kind != 2) {
#pragma unroll
        for (int ai = 0; ai < 2; ++ai)
#pragma unroll
            for (int m = 0; m < 4; ++m) {
                const int row = row0 + ai * HALF + m * 16;
                const int cidx = row >> 6, tau = row & 63;
#pragma unroll
                for (int bj = 0; bj < 2; ++bj) {
                    f32x4 v0 = acc[ai][bj][m][0] + bv[bj][0], v1 = acc[ai][bj][m][1] + bv[bj][1];
                    if (act == 1) {
#pragma unroll
                        for (int e = 0; e < 4; ++e) { v0[e] = sigmoid_f(v0[e]); v1[e] = sigmoid_f(v1[e]); }
                    } else if (act == 2) {
#pragma unroll
                        for (int e = 0; e < 4; ++e) { v0[e] = silu_f(v0[e]); v1[e] = silu_f(v1[e]); }
                    } else { v0 = v0 * sc; v1 = v1 * sc; }
                    u32x4 w; w.x = pk_bf16(v0[0], v0[1]); w.y = pk_bf16(v0[2], v0[3]); w.z = pk_bf16(v1[0], v1[1]); w.w = pk_bf16(v1[2], v1[3]);
                    const int c0 = col0 + bj * HALF;
                    if (kind <= 1) {
                        const int hh = c0 >> 7, dk0 = c0 & 127;
                        const size_t fi = ((((size_t)((cidx >> 6) * 8 + hh) * 64 + (cidx & 63)) * 2 + (tau >> 5)) * 8 + (dk0 >> 4)) * 64 + ((dk0 >> 3) & 1) * 32 + (tau & 31);
                        *(u32x4*)(dst + fi * 8) = w;
                    } else {
                        const int hh = c0 >> 8, d8 = (c0 & 255) >> 3;
                        const size_t fi = ((((size_t)((cidx >> 6) * 8 + hh) * 64 + (cidx & 63)) * 2 + (tau >> 5)) * 32 + d8) * 64 + (tau & 31);
                        *(u32x2*)(dst + fi * 4) = (u32x2){w.x, w.y}; *(u32x2*)(dst + (fi + 32) * 4) = (u32x2){w.z, w.w};
                    }
                }
            }
        }
        if (kind == 1 || kind == 2) {
            const int hshift = kind == 1 ? 7 : 8, nblk = kind == 1 ? 4 : 8;
            const int lane = fq * 16 + fr;
            LAS unsigned char* my = tlds + (wr * 4 + wc) * 1152;
            LAS unsigned char* wp = my + (4 * fq) * 72 + fr * 2;
            const LAS unsigned char* rp = my + (lane >> 2) * 72 + ((lane >> 1) & 1) * 32 + (lane & 1) * 8;
            const int ccol0 = colt + wc * 32 + 8 * (lane >> 4) + ((lane >> 2) & 3);
            const int rrow0 = u.pm * BM + wr * 64;
#pragma unroll
            for (int ai = 0; ai < 2; ++ai)
#pragma unroll
                for (int bj = 0; bj < 2; ++bj)
#pragma unroll
                    for (int n = 0; n < 2; ++n)
#pragma unroll
                        for (int mp = 0; mp < 2; ++mp) {
#pragma unroll
                            for (int mm = 0; mm < 2; ++mm) {
                                const f32x4 v = acc[ai][bj][2 * mp + mm][n] + bv[bj][n];
                                const unsigned p01 = pk_bf16(v[0], v[1]), p23 = pk_bf16(v[2], v[3]);
                                *(LAS unsigned short*)(wp + 0 * 72 + 32 * mm) = (unsigned short)(p01 & 0xffffu); *(LAS unsigned short*)(wp + 1 * 72 + 32 * mm) = (unsigned short)(p01 >> 16);
                                *(LAS unsigned short*)(wp + 2 * 72 + 32 * mm) = (unsigned short)(p23 & 0xffffu); *(LAS unsigned short*)(wp + 3 * 72 + 32 * mm) = (unsigned short)(p23 >> 16);
                            }
                            asm volatile("" ::: "memory");
                            const u32x2 lo = *(const LAS u32x2*)(rp), hi = *(const LAS u32x2*)(rp + 16);
                            asm volatile("" ::: "memory");
                            const int rr = rrow0 + ai * HALF + 32 * mp, cidx = rr >> 6, ks = ((rr & 63) >> 4) + ((lane >> 1) & 1);
                            const int cc = ccol0 + bj * HALF + 4 * n, hh = cc >> hshift, rowi = cc & ((1 << hshift) - 1);
                            const size_t fi = ((((size_t)((cidx >> 6) * 8 + hh) * 64 + (cidx & 63)) * nblk + (rowi >> 5)) * 4 + ks) * 64 + (lane & 1) * 32 + (rowi & 31);
                            *(u32x4*)(dstT + fi * 8) = (u32x4){lo.x, lo.y, hi.x, hi.y};
                        }
        }
    }
};

struct MergeOrder {
    StaticOrder so;
    __device__ bool next(int i, Unit& u) const { if (!so.next(i >> 1, u)) return false; u.which = i & 1; return true; }
};
struct EpiMerge {
    static __device__ __forceinline__ bool keeps_acc(const Unit& u) { return u.which == 0; }
    static constexpr bool PERM = true; static constexpr bool LDS_CONST = false; static constexpr bool KHOOK = false;
    const bf16_t* RR; const bf16_t* GB; bf16_t* MG;
    __device__ __forceinline__ void operator()(f32x4 (&acc)[2][2][4][2], const Unit& u, int wr, int wc, int fr, int fq) const {
        const int row0 = u.pm * BM + wr * 64 + fr, col0 = u.pn * BM + wc * 32 + 8 * fq;
        const bf16_t* src = u.which == 0 ? RR : GB;
        u32x4 gv[2][4][2];
#pragma unroll
        for (int ai = 0; ai < 2; ++ai)
#pragma unroll
            for (int m = 0; m < 4; ++m)
#pragma unroll
                for (int bj = 0; bj < 2; ++bj) gv[ai][m][bj] = *(const u32x4*)(src + ((((((size_t)(u.pm * 2 + ai) * 2 + wr) * 4 + m) * 16 + (2 * u.pn + bj)) * 4 + wc) * 64 + fq * 16 + fr) * 8);
        asm volatile("" ::: "memory");
#pragma unroll
        for (int ai = 0; ai < 2; ++ai)
#pragma unroll
            for (int m = 0; m < 4; ++m) {
#pragma unroll
                for (int bj = 0; bj < 2; ++bj) {
                    const size_t off = ktm((size_t)(row0 + ai * HALF + m * 16), col0 + bj * HALF, 32);
                    const u32x4 g = gv[ai][m][bj];
                    f32x4 g0 = {bf_lo(g.x), bf_hi(g.x), bf_lo(g.y), bf_hi(g.y)}, g1 = {bf_lo(g.z), bf_hi(g.z), bf_lo(g.w), bf_hi(g.w)};
                    const f32x4 t0 = acc[ai][bj][m][0] * g0, t1 = acc[ai][bj][m][1] * g1;
                    if (u.which == 0) { acc[ai][bj][m][0] = t0; acc[ai][bj][m][1] = t1; }
                    else { u32x4 w; w.x = pk_bf16(t0[0], t0[1]); w.y = pk_bf16(t0[2], t0[3]); w.z = pk_bf16(t1[0], t1[1]); w.w = pk_bf16(t1[2], t1[3]); *(u32x4*)(MG + off) = w; }
                }
            }
    }
};
struct PanelOrder {
    int vcu;
    __device__ bool next(int i, Unit& u) const { if (i >= 2) return false; u.pm = 32 * i + (vcu >> 3); u.pn = vcu & 7; u.which = 0; return true; }
};
struct EpiOutNorm {
    static __device__ __forceinline__ bool keeps_acc(const Unit&) { return false; }
    static constexpr bool PERM = false; static constexpr bool LDS_CONST = false; static constexpr bool KHOOK = true;
    const float* X; const float* gate; const float* nfw; float* O; float* rowss; unsigned* cnt;
    __device__ __forceinline__ const float* hook_base(const Unit& u) const { return X + (size_t)(u.pm * BM) * DM + u.pn * BM; }
    __device__ __forceinline__ void operator()(f32x4 (&acc)[2][2][4][2], const Unit& u, int wr, int wc, int fr, int fq) const {
        asm volatile("" : "+v"(fr), "+v"(fq));
        const int row0 = u.pm * BM + wr * 64 + fr, col0 = u.pn * BM + wc * 32 + 4 * fq;
        float rs[2][4];
#pragma unroll
        for (int ai = 0; ai < 2; ++ai)
#pragma unroll
            for (int m = 0; m < 4; ++m) {
                float q = 0.f;
#pragma unroll
                for (int bj = 0; bj < 2; ++bj)
#pragma unroll
                    for (int n = 0; n < 2; ++n) { const f32x4 v = acc[ai][bj][m][n]; q += (v[0] * v[0] + v[1] * v[1]) + (v[2] * v[2] + v[3] * v[3]); }
                q += __shfl_xor(q, 16); q += __shfl_xor(q, 32);
                rs[ai][m] = q;
            }
        float sink = 0.f;
        if (fq == 0) {
#pragma unroll
            for (int ai = 0; ai < 2; ++ai)
#pragma unroll
                for (int m = 0; m < 4; ++m) sink += __hip_atomic_fetch_add(rowss + row0 + ai * HALF + m * 16, rs[ai][m], __ATOMIC_RELAXED, __HIP_MEMORY_SCOPE_AGENT);
        }
        asm volatile("s_waitcnt vmcnt(0)" :: "v"(sink) : "memory");
        unsigned* cp = cnt + 64 * u.pm;
        if (fq == 0 && fr == 0) (void)__hip_atomic_fetch_add(cp, 1u, __ATOMIC_RELAXED, __HIP_MEMORY_SCOPE_AGENT);
        {
            unsigned spins = 0;
            while ((unsigned)__builtin_amdgcn_readfirstlane(__hip_atomic_load(cp, __ATOMIC_RELAXED, __HIP_MEMORY_SCOPE_AGENT)) < 64u) { __builtin_amdgcn_s_sleep(2); if (++spins > (1u << 22)) break; }
        }
        asm volatile("" ::: "memory");
        float rstd[2][4];
#pragma unroll
        for (int ai = 0; ai < 2; ++ai)
#pragma unroll
            for (int m = 0; m < 4; ++m) rstd[ai][m] = rsqrtf(__hip_atomic_load(rowss + row0 + ai * HALF + m * 16, __ATOMIC_RELAXED, __HIP_MEMORY_SCOPE_AGENT) * (1.f / DM) + EPS);
        f32x4 wv[2][2];
#pragma unroll
        for (int bj = 0; bj < 2; ++bj)
#pragma unroll
            for (int n = 0; n < 2; ++n) wv[bj][n] = *(const f32x4*)(nfw + col0 + bj * HALF + n * 16);
        const bool lo8 = fr < 8;
        float* oA = O + (size_t)(u.pm * BM + wr * 64 + (fr & 7)) * DM + u.pn * BM + wc * 32 + 4 * fq + (lo8 ? 0 : 16);
        float* oB = O + (size_t)(u.pm * BM + wr * 64 + 8 + (fr & 7)) * DM + u.pn * BM + wc * 32 + 4 * fq + (lo8 ? 16 : 0);
#pragma unroll
        for (int ai = 0; ai < 2; ++ai)
#pragma unroll
            for (int m = 0; m < 4; ++m) {
                const size_t off = (size_t)(ai * HALF + m * 16) * DM;
#pragma unroll
                for (int bj = 0; bj < 2; ++bj) {
                    const f32x4 v0 = acc[ai][bj][m][0] * rstd[ai][m] * wv[bj][0], v1 = acc[ai][bj][m][1] * rstd[ai][m] * wv[bj][1];
                    const f32x4 t1 = ror8(v1);
                    f32x4 dA, dB;
#pragma unroll
                    for (int e = 0; e < 4; ++e) { dA[e] = lo8 ? v0[e] : t1[e]; dB[e] = lo8 ? t1[e] : v0[e]; }
                    *(f32x4*)(oA + off + bj * HALF) = dA; *(f32x4*)(oB + off + bj * HALF) = dB;
                }
            }
    }
};
}

constexpr size_t MiB = 1u << 20;
constexpr size_t WS_CTL = 0, CTL_ZERO_BYTES = 73728 * 4;
constexpr size_t WS_MISC = 1 * MiB;
constexpr size_t WS_WINT = 8 * MiB;
constexpr size_t WS_H = 88 * MiB;
constexpr size_t WS_CT = 8 * MiB;
constexpr size_t WS_MG = 8 * MiB;
constexpr size_t WS_WAB = 152 * MiB;
constexpr size_t WS_WO = 168 * MiB;
constexpr size_t WS_Q = 176 * MiB, WS_K = 208 * MiB, WS_VT = 240 * MiB, WS_KT = 304 * MiB;
constexpr size_t WS_OG = 336 * MiB, WS_ZA = 400 * MiB, WS_HAB = 464 * MiB;
constexpr size_t WS_SB = 592 * MiB;
constexpr size_t WS_WOS = 604 * MiB;
constexpr size_t WS_END = 636 * MiB;
constexpr int CW_BAR = 0;
constexpr int CW_MOD = 28672;
constexpr int CW_ROWSS = 53248;
constexpr int CW_CNT = 69632;
constexpr size_t MI_BPERM = 0;
constexpr size_t MI_AMX = 32768, MI_GS = MI_AMX + 4096, MI_MS = MI_GS + 4096;
constexpr size_t MI_AA = 65536, MI_CM = MI_AA + 131072, MI_BB = MI_CM + 131072;
constexpr size_t MI_NJ = MI_BB + 131072;
constexpr size_t MI_WIF = MI_NJ + 262144;
static_assert((MI_WIF + 32768) * 4 <= 7 * MiB, "misc map");

constexpr int NWAVES = 8;
constexpr int LDS_BYTES = 147456;

#define GAS __attribute__((address_space(1)))
typedef GAS unsigned gu32;
#define RLX_AGENT __ATOMIC_RELAXED, __HIP_MEMORY_SCOPE_AGENT

#define XB_TMO      128
#define XB_XCNT(j)  (256  + 64 * (j))
#define XB_XSUB(j)  (1280 + 64 * (j))
#define XB_XGEN(j)  (2304 + 64 * (j))
#define XB_TOP      3328
#define XB_TOPGEN   3392
#define XCD_BAR_WORDS 3456
#define XB_SPIN_CAP (1u << 18)
__device__ __forceinline__ unsigned xb_ld(unsigned* p)              { return __hip_atomic_load(p, __ATOMIC_RELAXED, __HIP_MEMORY_SCOPE_AGENT); }
__device__ __forceinline__ unsigned xb_add(unsigned* p, unsigned v) { return __hip_atomic_fetch_add(p, v, __ATOMIC_RELAXED, __HIP_MEMORY_SCOPE_AGENT); }
__device__ __forceinline__ unsigned xb_xcc_id() { return (unsigned)__builtin_amdgcn_s_getreg((3 << 11) | 20) & 0xFu; }
#define XB_SPIN(cond, bar) do { unsigned _sp = 0; while (cond) { __builtin_amdgcn_s_sleep(1); \
    if ((++_sp & 255u) == 0u) { if (xb_ld(&(bar)[XB_TMO])) break; if (_sp > XB_SPIN_CAP) { atomicAdd(&(bar)[XB_TMO], 1u); break; } } } } while (0)
struct XcdBarrier { unsigned* bar; unsigned x; volatile LAS unsigned* st; };
__device__ __forceinline__ XcdBarrier xcd_barrier_post(unsigned* bar, volatile LAS unsigned* st) {
    XcdBarrier b; b.bar = bar; b.x = xb_xcc_id(); b.st = st;
    if (threadIdx.x == 0) (void)xb_add(&bar[XB_XCNT(b.x)], 1u);
    return b;
}
__device__ __forceinline__ void xcd_barrier_complete(unsigned* bar, unsigned x, unsigned& nloc, unsigned& nx) {
    const unsigned G = gridDim.x * gridDim.y * gridDim.z;
    unsigned sum, cnt, mine, sp = 0u;
    for (;;) {
        sum = 0u; cnt = 0u; mine = 0u;
#pragma unroll
        for (unsigned j = 0; j < 16; ++j) { const unsigned c = xb_ld(&bar[XB_XCNT(j)]); sum += c; cnt += (c > 0u) ? 1u : 0u; mine = (j == x) ? c : mine; }
        if (sum == G) break;
        __builtin_amdgcn_s_sleep(1);
        if ((++sp & 255u) == 0u) { if (xb_ld(&bar[XB_TMO])) break; if (sp > XB_SPIN_CAP) { atomicAdd(&bar[XB_TMO], 1u); break; } }
    }
    nloc = mine > 0u ? mine : 1u; nx = cnt > 0u ? cnt : 1u;
}
__device__ __forceinline__ void xcd_barrier(const XcdBarrier& b) {
    asm volatile("s_waitcnt vmcnt(0)" ::: "memory");
    __syncthreads();
    if (threadIdx.x == 0) {
        unsigned* bar = b.bar;
        __builtin_amdgcn_s_waitcnt(0);
        unsigned nloc = b.st[0], nx = b.st[1];
        if (nloc == 0u) { xcd_barrier_complete(bar, b.x, nloc, nx); b.st[0] = nloc; b.st[1] = nx; }
        const unsigned old = xb_add(&bar[XB_XSUB(b.x)], 1u);
        const unsigned gen = old / nloc;
        if (old + 1u == (gen + 1u) * nloc) {
            __builtin_amdgcn_fence(__ATOMIC_RELEASE, "agent");
            asm volatile("s_waitcnt vmcnt(0)" ::: "memory");
            const unsigned og = xb_add(&bar[XB_TOP], 1u);
            const unsigned tg = og / nx;
            if (og + 1u == (tg + 1u) * nx) xb_add(&bar[XB_TOPGEN], 1u);
            else XB_SPIN(xb_ld(&bar[XB_TOPGEN]) == tg, bar);
            __builtin_amdgcn_fence(__ATOMIC_ACQUIRE, "agent");
            xb_add(&bar[XB_XGEN(b.x)], 1u);
            asm volatile("s_waitcnt vmcnt(0)" ::: "memory");
        } else {
            XB_SPIN(xb_ld(&bar[XB_XGEN(b.x)]) == gen, bar);
            __builtin_amdgcn_fence(__ATOMIC_ACQUIRE, "agent");
            asm volatile("s_waitcnt vmcnt(0)" ::: "memory");
        }
    }
    __syncthreads();
}

struct Args { const float* in[13]; float* out; unsigned char* ws; int ph_lo, ph_hi, li, pad; };

template <class ColFn>
__device__ __forceinline__ void p0_transpose_item(const float* W, int ldw, bf16_t* WT, int ldt, int koff, int k0, int n0, ColFn colfn, LAS float* scr, int lane) {
    const int sc = colfn(n0 + 4 * (lane & 7));
    f32x4 v[8];
#pragma unroll
    for (int i = 0; i < 8; ++i) v[i] = *(const f32x4*)(W + (size_t)(k0 + 8 * i + (lane >> 3)) * ldw + sc);
#pragma unroll
    for (int i = 0; i < 8; ++i) { LAS float* d = scr + (8 * i + (lane >> 3)) * 33 + 4 * (lane & 7); d[0] = v[i][0]; d[1] = v[i][1]; d[2] = v[i][2]; d[3] = v[i][3]; }
    asm volatile("s_waitcnt lgkmcnt(0)" ::: "memory");
    const int c = lane & 7;
#pragma unroll
    for (int j = 0; j < 4; ++j) { const int n = (lane >> 3) + 8 * j; const LAS float* s = scr + (8 * c) * 33 + n;
        u32x4 o; o.x = pk_bf16(s[0 * 33], s[1 * 33]); o.y = pk_bf16(s[2 * 33], s[3 * 33]); o.z = pk_bf16(s[4 * 33], s[5 * 33]); o.w = pk_bf16(s[6 * 33], s[7 * 33]);
        *(u32x4*)(WT + (size_t)(n0 + n) * ldt + koff + k0 + 8 * c) = o; }
    asm volatile("s_waitcnt lgkmcnt(0)" ::: "memory");
}

struct P0Item { const float* src; bf16_t* dst; int ldw, ldt; };
__device__ __forceinline__ P0Item p0_item(const Args& a, unsigned char* ws, int it, int lane) {
    constexpr int I_IN = 32 * 640, I_SQ = 32 * 64;
    P0Item p;
    if (it < I_IN) {
        const int kb = it / 640, nb = it % 640;
        p.src = a.in[5] + (size_t)(64 * kb) * INW + win_src_col(32 * nb + 4 * (lane & 7)); p.ldw = INW;
        p.dst = (bf16_t*)(ws + WS_WINT) + pg8::ktm((size_t)(32 * nb), 64 * kb, 32); p.ldt = 64;
    } else {
        const int r0 = it - I_IN, mat = r0 / I_SQ, r = r0 % I_SQ, kb = r / 64, nb = r % 64;
        const float* W = mat == 0 ? a.in[9] : a.in[10];
        p.src = W + (size_t)(64 * kb) * DM + 32 * nb + 4 * (lane & 7); p.ldw = DM;
        p.ldt = 64;
        p.dst = (bf16_t*)(ws + WS_WAB) + pg8::ktm((size_t)(32 * nb), (mat == 1 ? 2048 : 0) + 64 * kb, 64);
    }
    return p;
}
__device__ __forceinline__ void p0_item_load(const P0Item& p, f32x4 (&v)[8], int lane) {
#pragma unroll
    for (int i = 0; i < 8; ++i) v[i] = *(const f32x4*)(p.src + (size_t)(8 * i + (lane >> 3)) * p.ldw);
}
__device__ __forceinline__ void p0_item_finish(const P0Item& p, const f32x4 (&v)[8], LAS float* scr, int lane) {
#pragma unroll
    for (int i = 0; i < 8; ++i) { LAS float* d = scr + (8 * i + (lane >> 3)) * 33 + 4 * (lane & 7); d[0] = v[i][0]; d[1] = v[i][1]; d[2] = v[i][2]; d[3] = v[i][3]; }
    asm volatile("s_waitcnt lgkmcnt(0)" ::: "memory");
    const int c = lane & 7;
#pragma unroll
    for (int j = 0; j < 4; ++j) { const int n = (lane >> 3) + 8 * j; const LAS float* sp = scr + (8 * c) * 33 + n;
        u32x4 o; o.x = pk_bf16(sp[0 * 33], sp[1 * 33]); o.y = pk_bf16(sp[2 * 33], sp[3 * 33]); o.z = pk_bf16(sp[4 * 33], sp[5 * 33]); o.w = pk_bf16(sp[6 * 33], sp[7 * 33]);
        *(u32x4*)(p.dst + (size_t)n * p.ldt + 8 * c) = o; }
    asm volatile("s_waitcnt lgkmcnt(0)" ::: "memory");
}

__device__ __forceinline__ void p0_prep(const Args& a, LAS unsigned char* lds, int tid, int lane, int wave, int vcu, int G) {
    unsigned char* ws = a.ws;
    const float* c_in = a.in[1]; const float* w_ada = a.in[3]; const float* b_ada = a.in[4]; const float* w_in = a.in[5]; const float* b_in = a.in[6];
    float* MOD = (float*)(ws + WS_CTL) + CW_MOD;
    {
        const int bx = blockIdx.x, cg = bx & 7, ks = bx >> 3;
        if (ks < 32) {
            LAS float* cact = (LAS float*)(lds + 100 * 1024);
            if (tid < 256) { const int b = tid >> 6, kk = tid & 63; cact[tid] = silu_acc(c_in[b * DM + ks * 64 + kk]); }
            f32x4 wv[8][3];
#pragma unroll
            for (int kk = 0; kk < 8; ++kk)
#pragma unroll
                for (int j = 0; j < 3; ++j) wv[kk][j] = *(const f32x4*)(w_ada + (size_t)(ks * 64 + wave * 8 + kk) * 6144 + cg * 768 + 256 * j + 4 * lane);
            __syncthreads();
            f32x4 acc[4][3];
#pragma unroll
            for (int b = 0; b < 4; ++b)
#pragma unroll
                for (int j = 0; j < 3; ++j) acc[b][j] = (f32x4){0.f, 0.f, 0.f, 0.f};
#pragma unroll
            for (int kk = 0; kk < 8; ++kk) {
                float ca[4];
#pragma unroll
                for (int b = 0; b < 4; ++b) ca[b] = cact[b * 64 + wave * 8 + kk];
#pragma unroll
                for (int j = 0; j < 3; ++j)
#pragma unroll
                    for (int b = 0; b < 4; ++b) acc[b][j] += wv[kk][j] * ca[b];
            }
            LAS f32x4* red = (LAS f32x4*)lds;
#pragma unroll
            for (int b = 0; b < 4; ++b)
#pragma unroll
                for (int j = 0; j < 3; ++j) red[(wave * 12 + b * 3 + j) * 64 + lane] = acc[b][j];
            __syncthreads();
            for (int idx = tid; idx < 768; idx += 512) {
                const int bj = idx >> 6, ln = idx & 63, b = bj / 3, j = bj % 3;
                f32x4 s = (f32x4){0.f, 0.f, 0.f, 0.f};
#pragma unroll
                for (int w = 0; w < 8; ++w) s += red[(w * 12 + bj) * 64 + ln];
                const int col = cg * 768 + 256 * j + 4 * ln;
                if (ks == 0) s += *(const f32x4*)(b_ada + col);
                float* mp = MOD + b * 6144 + col;
                atomicAdd(mp + 0, s[0]); atomicAdd(mp + 1, s[1]); atomicAdd(mp + 2, s[2]); atomicAdd(mp + 3, s[3]);
            }
            __syncthreads();
        }
    }
    {
        LAS float* scr = (LAS float*)(lds + wave * 16384);
        const int gw = vcu * NWAVES + wave, NGW = G * NWAVES;
        constexpr int NITEMS = 32 * 640 + 2 * 32 * 64;
        if (NGW * 12 == NITEMS) {
            P0Item I0 = p0_item(a, ws, gw, lane), I1;
            f32x4 v0[8], v1[8];
            p0_item_load(I0, v0, lane);
#pragma unroll 1
            for (int k = 0; k < 10; k += 2) {
                I1 = p0_item(a, ws, gw + (k + 1) * NGW, lane); p0_item_load(I1, v1, lane); p0_item_finish(I0, v0, scr, lane);
                I0 = p0_item(a, ws, gw + (k + 2) * NGW, lane); p0_item_load(I0, v0, lane); p0_item_finish(I1, v1, scr, lane);
            }
            I1 = p0_item(a, ws, gw + 11 * NGW, lane); p0_item_load(I1, v1, lane); p0_item_finish(I0, v0, scr, lane);
            p0_item_finish(I1, v1, scr, lane);
        } else {
            for (int it = gw; it < NITEMS; it += NGW) { const P0Item I = p0_item(a, ws, it, lane); f32x4 v[8]; p0_item_load(I, v, lane); p0_item_finish(I, v, scr, lane); }
        }
        float* bperm = (float*)(ws + WS_MISC) + MI_BPERM;
        for (int i = blockIdx.x * 512 + tid; i < NPRJ; i += G * 512) bperm[i] = b_in[win_src_col(i)];
        float* wif = (float*)(ws + WS_MISC) + MI_WIF;
        for (int i = blockIdx.x * 512 + tid; i < 2048 * 16; i += G * 512) wif[i] = w_in[(size_t)(i >> 4) * INW + O_IF + (i & 15)];
    }
}

__device__ __forceinline__ void p1_hnorm(const Args& a, LAS unsigned char* lds, int tid, int lane, int wave, int G) {
    unsigned char* ws = a.ws;
    const float* x = a.in[0]; const float* nw = a.in[2]; const float* w_in = a.in[5]; const float* b_in = a.in[6];
    const float* MOD = (const float*)(ws + WS_CTL) + CW_MOD;
    bf16_t* Hb = (bf16_t*)(ws + WS_H);
    float* misc = (float*)(ws + WS_MISC);
    LAS f32x4* wl = (LAS f32x4*)lds;
    LAS float* gl = (LAS float*)(lds + 131072);
    for (int it = blockIdx.x * NWAVES + wave; it < 32 * 64; it += G * NWAVES) {
        const int kb = it / 64, nb = it % 64;
        LAS float* scr = (LAS float*)(lds + wave * 16384);
        const float* src = a.in[11] + (size_t)(64 * kb) * DM + 32 * nb + 4 * (lane & 7);
        f32x4 v[8];
#pragma unroll
        for (int i = 0; i < 8; ++i) v[i] = *(const f32x4*)(src + (size_t)(8 * i + (lane >> 3)) * DM);
        float gt[4][4];
#pragma unroll
        for (int j = 0; j < 4; ++j)
#pragma unroll
            for (int bb = 0; bb < 4; ++bb) gt[j][bb] = MOD[bb * 6144 + 4096 + 32 * nb + (lane >> 3) + 8 * j];
#pragma unroll
        for (int i = 0; i < 8; ++i) { LAS float* d = scr + (8 * i + (lane >> 3)) * 33 + 4 * (lane & 7); d[0] = v[i][0]; d[1] = v[i][1]; d[2] = v[i][2]; d[3] = v[i][3]; }
        asm volatile("s_waitcnt lgkmcnt(0)" ::: "memory");
        const int c = lane & 7;
#pragma unroll
        for (int j = 0; j < 4; ++j) {
            const int n = (lane >> 3) + 8 * j; const LAS float* sp = scr + (8 * c) * 33 + n;
            float e[8];
#pragma unroll
            for (int q = 0; q < 8; ++q) e[q] = sp[q * 33];
#pragma unroll
            for (int bb = 0; bb < 4; ++bb) {
                const float gg = gt[j][bb];
                u32x4 o; o.x = pk_bf16(e[0] * gg, e[1] * gg); o.y = pk_bf16(e[2] * gg, e[3] * gg); o.z = pk_bf16(e[4] * gg, e[5] * gg); o.w = pk_bf16(e[6] * gg, e[7] * gg);
                *(u32x4*)((bf16_t*)(ws + WS_WOS) + (size_t)bb * DM * DM + pg8::ktm((size_t)(32 * nb + n), 64 * kb + 8 * c, 32)) = o;
            }
        }
        asm volatile("s_waitcnt lgkmcnt(0)" ::: "memory");
    }
    __syncthreads();
    {
        const f32x4* wif4 = (const f32x4*)(misc + MI_WIF);
#pragma unroll 1
        for (int hb = 0; hb < 2; ++hb) {
            f32x4 wq[8];
#pragma unroll
            for (int i = 0; i < 8; ++i) wq[i] = wif4[tid + 512 * (8 * hb + i)];
#pragma unroll
            for (int i = 0; i < 8; ++i) { const int q4 = tid + 512 * (8 * hb + i), k = q4 >> 2, gq = q4 & 3, e = k & 3, l = (k >> 2) & 63, jx = k >> 8; wl[((e * 8 + jx) * 4 + gq) * 64 + l] = wq[i]; }
        }
    }
    __syncthreads();
    const int gw = blockIdx.x * NWAVES + wave;
    const int rbase = gw * 8, b = rbase >> 12;
    f32x4 ms[8], sh[8];
#pragma unroll
    for (int j = 0; j < 8; ++j) {
        const int k = 4 * lane + 256 * j;
        const f32x4 nv = *(const f32x4*)(nw + k), scv = *(const f32x4*)(MOD + b * 6144 + 2048 + k);
        ms[j] = nv * (scv + 1.0f); sh[j] = *(const f32x4*)(MOD + b * 6144 + k);
    }
    for (int i = 0; i < 8; ++i) {
        const int row = rbase + i;
        const f32x4* xr = (const f32x4*)(x + (size_t)row * DM) + lane;
        f32x4 v[8]; float ss = 0.f;
#pragma unroll
        for (int j = 0; j < 8; ++j) { v[j] = xr[64 * j]; ss += (v[j][0] * v[j][0] + v[j][1] * v[j][1]) + (v[j][2] * v[j][2] + v[j][3] * v[j][3]); }
        const float rstd = rsqrtf(wave_sum(ss) * (1.f / DM) + EPS);
        f32x4 acc[4];
#pragma unroll
        for (int gq = 0; gq < 4; ++gq) acc[gq] = (f32x4){0.f, 0.f, 0.f, 0.f};
        u32x2* hrow = (u32x2*)(Hb + (size_t)row * DM) + lane;
#pragma unroll
        for (int j = 0; j < 8; ++j) {
            const f32x4 hv = v[j] * rstd * ms[j] + sh[j];
            u32x2 w; w.x = pk_bf16(hv[0], hv[1]); w.y = pk_bf16(hv[2], hv[3]);
            hrow[64 * j] = w;
#pragma unroll
            for (int e = 0; e < 4; ++e)
#pragma unroll
                for (int gq = 0; gq < 4; ++gq) acc[gq] += wl[((e * 8 + j) * 4 + gq) * 64 + lane] * hv[e];
            asm volatile("" ::: "memory");
        }
        float mine = 0.f;
#pragma unroll
        for (int gq = 0; gq < 4; ++gq)
#pragma unroll
            for (int e = 0; e < 4; ++e) { const float sgs = wave_sum(acc[gq][e]); mine = (lane == gq * 4 + e) ? sgs : mine; }
        if (lane < 16) {
            const float pre = mine + b_in[O_IF + lane];
            gl[lane * 64 + wave * 8 + i] = lane < 8 ? pre : (fminf(pre, 0.f) - log1pf(expf(-fabsf(pre))));
        }
    }
    __syncthreads();
    {
        const int hh = wave, jc = blockIdx.x & 63, bh = b * 8 + hh;
        const float li = gl[hh * 64 + lane], lf = gl[(8 + hh) * 64 + lane];
        float bc = lf;
#pragma unroll
        for (int o = 1; o < 64; o <<= 1) { const float t = __shfl_up(bc, o); if (lane >= o) bc += t; }
        const float av = li - bc;
        float cm = av;
#pragma unroll
        for (int o = 1; o < 64; o <<= 1) { const float t = __shfl_up(cm, o); if (lane >= o) cm = fmaxf(cm, t); }
        const size_t ti = (size_t)bh * SEQ + jc * 64 + lane;
        misc[MI_AA + ti] = av; misc[MI_CM + ti] = cm; misc[MI_BB + ti] = bc;
        if (lane == 63) { misc[MI_AMX + bh * 64 + jc] = cm; misc[MI_GS + bh * 64 + jc] = bc; }
    }
}

__device__ __forceinline__ f32x16 mfma32(bf16x8 a, bf16x8 b, f32x16 c) { return MFMA32(a, b, c); }

__device__ __forceinline__ void p3_scan(const Args& a, LAS unsigned char* lds, int tid, int lane, int wave, int vcu, int G) {
    unsigned char* ws = a.ws;
    {
        const float* SB = (const float*)(ws + WS_SB); const float* convw = a.in[7]; bf16_t* HB = (bf16_t*)(ws + WS_HAB);
        for (int idx = blockIdx.x * 512 + tid; idx < 256 * 512; idx += G * 512) {
            const int g = idx >> 9, ch = (idx & 511) * 4;
            const float* sb = SB + (size_t)g * 6 * 2048 + ch;
            f32x4 c62 = (f32x4){0.f, 0.f, 0.f, 0.f}, c63 = c62;
            if ((g & 63) != 0) { c62 = *(const f32x4*)(sb - 6 * 2048); c63 = *(const f32x4*)(sb - 5 * 2048); }
            const f32x4 bz0 = *(const f32x4*)(sb + 2 * 2048), bz1 = *(const f32x4*)(sb + 3 * 2048), p0 = *(const f32x4*)(sb + 4 * 2048), p1 = *(const f32x4*)(sb + 5 * 2048);
            const f32x4 w0 = *(const f32x4*)(convw + ch), w1 = *(const f32x4*)(convw + 2048 + ch);
            const f32x4 h0 = bz0 * (p0 + w0 * c62 + w1 * c63), h1 = bz1 * (p1 + w0 * c63);
            u32x2 o0, o1; o0.x = pk_bf16(h0[0], h0[1]); o0.y = pk_bf16(h0[2], h0[3]); o1.x = pk_bf16(h1[0], h1[1]); o1.y = pk_bf16(h1[2], h1[3]);
            *(u32x2*)(HB + pg8::ktm((size_t)(64 * g), 2048 + ch, 64)) = o0; *(u32x2*)(HB + pg8::ktm((size_t)(64 * g + 1), 2048 + ch, 64)) = o1;
        }
    }
    const int xcd = vcu >> 5, cu = vcu & 31, slot = wave * 32 + cu;
    if (G != 256 || slot >= 144) return;
    const int bh = xcd * 4 + slot / 36, rem = slot % 36, ib = rem / 9, jv = rem % 9;
    const int b = bh >> 3, hh = bh & 7, r = lane & 31, h = lane >> 5;
    const bf16_t* KT = (const bf16_t*)(ws + WS_KT); const bf16_t* VT = (const bf16_t*)(ws + WS_VT);
    bf16_t* CT = (bf16_t*)(ws + WS_CT);
    float* misc = (float*)(ws + WS_MISC);
    const float* AAp = misc + MI_AA + (size_t)bh * SEQ + lane;
    float* NJ = misc + MI_NJ + (size_t)bh * 64 * 128;
    const bf16_t* ktp = KT + ((size_t)bh * 64 * 16 + ib * 4) * 512 + lane * 8;
    const bf16_t* vtp = VT + ((size_t)bh * 64 * 32 + (jv & 7) * 4) * 512 + lane * 8;
    LAS float* wsl = (LAS float*)(lds + wave * 256);
    float msv, m63v;
    {
        const float amx = misc[MI_AMX + bh * 64 + lane], gs = misc[MI_GS + bh * 64 + lane];
        float Gc = gs, Cc = gs + amx;
#pragma unroll
        for (int o = 1; o < 64; o <<= 1) { const float Gp = __shfl_up(Gc, o), Cp = __shfl_up(Cc, o); if (lane >= o) { Cc = fmaxf(Cp + Gc, Cc); Gc = Gp + Gc; } }
        const float mnext = fmaxf(Gc, Cc);
        msv = __shfl_up(mnext, 1); if (lane == 0) msv = 0.f;
        m63v = fmaxf(msv, amx);
        if (rem == 8) misc[MI_MS + bh * 64 + lane] = msv;
    }
    f32x16 acc;
#pragma unroll
    for (int i = 0; i < 16; ++i) acc[i] = 0.f;
    const u32x4 ones = (u32x4){ONES16, ONES16, ONES16, ONES16};
    struct OpSet { bf16x8 A[4]; u32x4 B[4]; float a; };
    auto load_set = [&](OpSet& S, int jj) {
        const int jc = jj < NCH ? jj : NCH - 1;
        S.a = AAp[64 * jc];
#pragma unroll
        for (int ks = 0; ks < 4; ++ks) { S.A[ks] = *(const bf16x8*)(ktp + (size_t)jc * 16 * 512 + 512 * ks); S.B[ks] = *(const u32x4*)(vtp + (size_t)jc * 32 * 512 + 512 * ks); }
    };
    auto step = [&](int j, const OpSet& S) {
        const float ms_j = __int_as_float(__builtin_amdgcn_readlane(__float_as_int(msv), j)), m63 = __int_as_float(__builtin_amdgcn_readlane(__float_as_int(m63v), j));
        const float wgt = __expf(S.a - m63), keep = __expf(ms_j - m63);
        wsl[lane] = wgt;
        if (jv < 8) {
            bf16_t* cp = CT + ((((size_t)(bh * 64 + j) * 8 + jv) * 8 + 2 * ib) * 64 + r) * 8 + 4 * h;
#pragma unroll
            for (int q = 0; q < 4; ++q) { u32x2 w; w.x = pk_bf16(acc[4 * q], acc[4 * q + 1]); w.y = pk_bf16(acc[4 * q + 2], acc[4 * q + 3]); *(u32x2*)(cp + ((q >> 1) * 64 + (q & 1) * 32) * 8) = w; }
        } else if (r == 0) {
            float* np = NJ + (size_t)j * 128 + 32 * ib + 4 * h;
#pragma unroll
            for (int q = 0; q < 4; ++q) *(f32x4*)(np + 8 * q) = (f32x4){acc[4 * q], acc[4 * q + 1], acc[4 * q + 2], acc[4 * q + 3]};
        }
        acc = acc * keep;
#pragma unroll
        for (int ks = 0; ks < 4; ++ks) {
            const u32x4 raw = (jv < 8) ? S.B[ks] : ones;
            const f32x4 wa = *(const LAS f32x4*)(wsl + 16 * ks + 4 * h), wb = *(const LAS f32x4*)(wsl + 16 * ks + 8 + 4 * h);
            u32x4 o;
            o.x = pk_bf16(bf_lo(raw.x) * wa[0], bf_hi(raw.x) * wa[1]); o.y = pk_bf16(bf_lo(raw.y) * wa[2], bf_hi(raw.y) * wa[3]);
            o.z = pk_bf16(bf_lo(raw.z) * wb[0], bf_hi(raw.z) * wb[1]); o.w = pk_bf16(bf_lo(raw.w) * wb[2], bf_hi(raw.w) * wb[3]);
            acc = mfma32(S.A[ks], __builtin_bit_cast(bf16x8, o), acc);
        }
    };
    OpSet S0, S1, S2, S3;
    load_set(S0, 0); load_set(S1, 1); load_set(S2, 2);
    for (int j = 0; j < NCH; j += 4) {
        load_set(S3, j + 3); step(j, S0);
        load_set(S0, j + 4); step(j + 1, S1);
        load_set(S1, j + 5); step(j + 2, S2);
        load_set(S2, j + 6); step(j + 3, S3);
    }
}

template <int LB>
__device__ __forceinline__ void p4_unit(const bf16_t* Q, const bf16_t* Kr, const bf16_t* VT, const bf16_t* CT, const bf16_t* OG, const bf16_t* ZA, bf16_t* HA,
                                        const float* misc, const float* hnw, LAS float* ssq, int unit, int par, int dvg, int lane) {
    const int r = lane & 31, h = lane >> 5, l = 32 * LB + r;
    const int bh = unit >> 6, j = unit & 63, b = bh >> 3, hh = bh & 7, t0 = 64 * j;
    const size_t tok = (size_t)b * SEQ + t0 + l;
    const float cml = misc[MI_CM + (size_t)bh * SEQ + t0 + l], bbl = misc[MI_BB + (size_t)bh * SEQ + t0 + l], mst = misc[MI_MS + bh * 64 + j];
    const float* AAp = misc + MI_AA + (size_t)bh * SEQ + t0 + 4 * h;
    const float* njp = misc + MI_NJ + ((size_t)bh * 64 + j) * 128 + 8 * h;
    bf16x8 qf[8], kf[LB + 1][8];
#pragma unroll
    for (int ks = 0; ks < 8; ++ks) qf[ks] = *(const bf16x8*)(Q + ((size_t)(unit * 2 + LB) * 8 + ks) * 512 + lane * 8);
#pragma unroll
    for (int sb = 0; sb <= LB; ++sb) {
#pragma unroll
        for (int ks = 0; ks < 8; ++ks) kf[sb][ks] = *(const bf16x8*)(Kr + ((size_t)(unit * 2 + sb) * 8 + ks) * 512 + lane * 8);
    }
    f32x4 a4[LB + 1][4];
#pragma unroll
    for (int sb = 0; sb <= LB; ++sb)
#pragma unroll
        for (int q = 0; q < 4; ++q) a4[sb][q] = *(const f32x4*)(AAp + 32 * sb + 8 * q);
    asm volatile("" ::: "memory");
    const float Ml = fmaxf(mst, cml), el = -bbl - Ml, winter = __expf(mst - Ml);
    f32x16 s[LB + 1];
#pragma unroll
    for (int sb = 0; sb <= LB; ++sb) {
#pragma unroll
        for (int i = 0; i < 16; ++i) s[sb][i] = 0.f;
#pragma unroll
        for (int ks = 0; ks < 8; ++ks) s[sb] = mfma32(kf[sb][ks], qf[ks], s[sb]);
    }
    u32x4 va[LB + 1][2][2];
#pragma unroll
    for (int sb = 0; sb <= LB; ++sb)
#pragma unroll
        for (int sp = 0; sp < 2; ++sp)
#pragma unroll
            for (int db = 0; db < 2; ++db) va[sb][sp][db] = *(const u32x4*)(VT + (((size_t)unit * 8 + 2 * dvg + db) * 4 + 2 * sb + sp) * 512 + lane * 8);
    bf16x8 cf[2][8];
#pragma unroll
    for (int ks = 0; ks < 8; ++ks) { cf[0][ks] = *(const bf16x8*)(CT + (((size_t)unit * 8 + 2 * dvg) * 8 + ks) * 512 + lane * 8); cf[1][ks] = *(const bf16x8*)(CT + (((size_t)unit * 8 + 2 * dvg + 1) * 8 + ks) * 512 + lane * 8); }
    asm volatile("" ::: "memory");
    f32x16 o0, o1;
#pragma unroll
    for (int i = 0; i < 16; ++i) { o0[i] = 0.f; o1[i] = 0.f; }
    float den = 0.f;
#pragma unroll
    for (int sb = 0; sb <= LB; ++sb) {
        float pv[16];
#pragma unroll
        for (int q = 0; q < 4; ++q)
#pragma unroll
            for (int e = 0; e < 4; ++e) {
                const int srow = 32 * sb + 8 * q + 4 * h + e;
                const float d = (sb < LB || srow <= l) ? __expf(a4[sb][q][e] - Ml) : 0.f;
                const float p = s[sb][4 * q + e] * d; pv[4 * q + e] = p; den += p;
            }
#pragma unroll
        for (int sp = 0; sp < 2; ++sp) {
            u32x4 pb; pb.x = pk_bf16(pv[8 * sp], pv[8 * sp + 1]); pb.y = pk_bf16(pv[8 * sp + 2], pv[8 * sp + 3]); pb.z = pk_bf16(pv[8 * sp + 4], pv[8 * sp + 5]); pb.w = pk_bf16(pv[8 * sp + 6], pv[8 * sp + 7]);
            const bf16x8 bfr = __builtin_bit_cast(bf16x8, pb);
            o0 = mfma32(__builtin_bit_cast(bf16x8, va[sb][sp][0]), bfr, o0);
            o1 = mfma32(__builtin_bit_cast(bf16x8, va[sb][sp][1]), bfr, o1);
        }
    }
    const size_t gzo = (((size_t)(unit * 2 + LB) * 32 + 8 * dvg) * 64 + lane) * 4;
    u32x2 og[2][4], za[2][4];
#pragma unroll
    for (int db = 0; db < 2; ++db)
#pragma unroll
        for (int q = 0; q < 4; ++q) { og[db][q] = *(const u32x2*)(OG + gzo + (4 * db + q) * 256); za[db][q] = *(const u32x2*)(ZA + gzo + (4 * db + q) * 256); }
    asm volatile("" ::: "memory");
    float deni = 0.f;
#pragma unroll
    for (int ks = 0; ks < 8; ++ks) {
        const u32x4 qr = __builtin_bit_cast(u32x4, qf[ks]);
        const float q0 = bf_lo(qr.x) * winter, q1 = bf_hi(qr.x) * winter, q2 = bf_lo(qr.y) * winter, q3 = bf_hi(qr.y) * winter;
        const float q4 = bf_lo(qr.z) * winter, q5 = bf_hi(qr.z) * winter, q6 = bf_lo(qr.w) * winter, q7 = bf_hi(qr.w) * winter;
        const f32x4 n0 = *(const f32x4*)(njp + 16 * ks), n1 = *(const f32x4*)(njp + 16 * ks + 4);
        deni += (q0 * n0[0] + q1 * n0[1]) + (q2 * n0[2] + q3 * n0[3]) + (q4 * n1[0] + q5 * n1[1]) + (q6 * n1[2] + q7 * n1[3]);
        u32x4 qs; qs.x = pk_bf16(q0, q1); qs.y = pk_bf16(q2, q3); qs.z = pk_bf16(q4, q5); qs.w = pk_bf16(q6, q7);
        const bf16x8 qb = __builtin_bit_cast(bf16x8, qs);
        o0 = mfma32(cf[0][ks], qb, o0);
        o1 = mfma32(cf[1][ks], qb, o1);
    }
    float dtot = den + deni; dtot += __shfl_xor(dtot, 32);
    const float inv = 1.f / fmaxf(fabsf(dtot), __expf(el));
    float hg[32]; float ss = 0.f;
#pragma unroll
    for (int q = 0; q < 4; ++q) {
        hg[4 * q + 0] = o0[4 * q + 0] * inv * bf_lo(og[0][q].x); hg[4 * q + 1] = o0[4 * q + 1] * inv * bf_hi(og[0][q].x); hg[4 * q + 2] = o0[4 * q + 2] * inv * bf_lo(og[0][q].y); hg[4 * q + 3] = o0[4 * q + 3] * inv * bf_hi(og[0][q].y);
        hg[16 + 4 * q + 0] = o1[4 * q + 0] * inv * bf_lo(og[1][q].x); hg[16 + 4 * q + 1] = o1[4 * q + 1] * inv * bf_hi(og[1][q].x); hg[16 + 4 * q + 2] = o1[4 * q + 2] * inv * bf_lo(og[1][q].y); hg[16 + 4 * q + 3] = o1[4 * q + 3] * inv * bf_hi(og[1][q].y);
    }
#pragma unroll
    for (int i = 0; i < 32; ++i) ss += hg[i] * hg[i];
    ss += __shfl_xor(ss, 32);
    if (h == 0) ssq[(par * 4 + dvg) * 64 + l] = ss;
    const float* hwp = hnw + hh * 256 + 64 * dvg + 4 * h;
    f32x4 hwv[2][4];
#pragma unroll
    for (int db = 0; db < 2; ++db)
#pragma unroll
        for (int q = 0; q < 4; ++q) hwv[db][q] = *(const f32x4*)(hwp + 32 * db + 8 * q);
    __syncthreads();
    const float tot = (ssq[(par * 4 + 0) * 64 + l] + ssq[(par * 4 + 1) * 64 + l]) + (ssq[(par * 4 + 2) * 64 + l] + ssq[(par * 4 + 3) * 64 + l]);
    const float rstd = rsqrtf(tot * (1.f / DV) + EPS);
    LAS unsigned char* patch = (LAS unsigned char*)ssq + 4096 + (dvg * 2 + LB) * 4608;
#pragma unroll
    for (int q = 0; q < 4; ++q) {
#pragma unroll
        for (int db = 0; db < 2; ++db) {
            const u32x2 z = za[db][q]; const f32x4 hw = hwv[db][q];
            const float v0 = hg[16 * db + 4 * q + 0] * rstd * hw[0] * bf_lo(z.x), v1 = hg[16 * db + 4 * q + 1] * rstd * hw[1] * bf_hi(z.x);
            const float v2 = hg[16 * db + 4 * q + 2] * rstd * hw[2] * bf_lo(z.y), v3 = hg[16 * db + 4 * q + 3] * rstd * hw[3] * bf_hi(z.y);
            u32x2 w; w.x = pk_bf16(v0, v1); w.y = pk_bf16(v2, v3);
            *(LAS u32x2*)(patch + r * 144 + (32 * db + 8 * q + 4 * h) * 2) = w;
        }
    }
    asm volatile("s_waitcnt lgkmcnt(0)" ::: "memory");
    bf16_t* hap = HA + pg8::ktm((size_t)b * SEQ + t0 + 32 * LB, hh * 256 + 64 * dvg, 64) + lane * 8;
#pragma unroll
    for (int i = 0; i < 4; ++i) {
        const u32x4 w = *(const LAS u32x4*)(patch + (8 * i + (lane >> 3)) * 144 + (lane & 7) * 16);
        *(u32x4*)(hap + i * 512) = w;
    }
}

__device__ __forceinline__ void p4_mlstm_out(const Args& a, LAS unsigned char* lds, int tid, int lane, int wave, int vcu, int G) {
    unsigned char* ws = a.ws;
    const bf16_t* Q = (const bf16_t*)(ws + WS_Q); const bf16_t* Kr = (const bf16_t*)(ws + WS_K); const bf16_t* VT = (const bf16_t*)(ws + WS_VT);
    const bf16_t* CT = (const bf16_t*)(ws + WS_CT); const bf16_t* OG = (const bf16_t*)(ws + WS_OG); const bf16_t* ZA = (const bf16_t*)(ws + WS_ZA);
    bf16_t* HA = (bf16_t*)(ws + WS_HAB);
    const float* misc = (const float*)(ws + WS_MISC); const float* hnw = a.in[8];
    LAS float* ssq = (LAS float*)lds;
    const int lb = wave & 1, dvg = wave >> 1;
    int par = 0;
    for (int unit = vcu; unit < 32 * NCH; unit += G, par ^= 1) {
        if (lb == 0) p4_unit<0>(Q, Kr, VT, CT, OG, ZA, HA, misc, hnw, ssq, unit, par, dvg, lane);
        else p4_unit<1>(Q, Kr, VT, CT, OG, ZA, HA, misc, hnw, ssq, unit, par, dvg, lane);
    }
}

constexpr int N_PHASES = 7;
__global__ void __launch_bounds__(NWAVES * 64, 2) fwd_kernel(Args args) {
    extern __shared__ __attribute__((aligned(16))) unsigned char lds_raw[];
    LAS unsigned char* lds = (LAS unsigned char*)lds_raw;
    const int tid = threadIdx.x, lane = tid & 63, wave = __builtin_amdgcn_readfirstlane(tid >> 6);
    const int G = gridDim.x; const int bx = blockIdx.x; const int vcu = (G % 8 == 0) ? (bx % 8) * (G / 8) + bx / 8 : bx;
    unsigned char* ws = args.ws;
    volatile LAS unsigned* bst = (volatile LAS unsigned*)(lds + LDS_BYTES - 64);
    if (tid < 16) bst[tid] = 0u;
    __syncthreads();
    XcdBarrier bar; bar.bar = (unsigned*)(ws + WS_CTL) + CW_BAR + args.li * XCD_BAR_WORDS; bar.x = 0; bar.st = nullptr;
    const int lo = args.ph_lo, hi = args.ph_hi;
    if (hi - lo > 1) bar = xcd_barrier_post((unsigned*)(ws + WS_CTL) + CW_BAR + args.li * XCD_BAR_WORDS, bst);
#ifndef PH_MASK
#define PH_MASK 0x7f
#endif
#define IN(k) (((PH_MASK >> (k)) & 1) && lo <= (k) && (k) < hi)
#define SEAM(k) do { if (IN(k) && IN((k) + 1)) xcd_barrier(bar); } while (0)
    if (IN(0)) { p0_prep(args, lds, tid, lane, wave, vcu, G); } SEAM(0);
    if (IN(1)) { p1_hnorm(args, lds, tid, lane, wave, G); } SEAM(1);
    if (IN(2)) {
        pg8::Gemm g{(const bf16_t*)(ws + WS_H), (const bf16_t*)(ws + WS_WINT), MTOK, NPRJ, DM, DM, 64, 0, 0, 128, 256 * DM * 2, 0, 32768, 32 * 32768};
        pg8::StaticOrder S; S.init(MTOK, NPRJ, G, bx);
        pg8::EpiInProj E{(bf16_t*)(ws + WS_Q), (bf16_t*)(ws + WS_K), (bf16_t*)(ws + WS_KT), (bf16_t*)(ws + WS_VT), (bf16_t*)(ws + WS_OG), (bf16_t*)(ws + WS_ZA),
                         (bf16_t*)(ws + WS_HAB), (bf16_t*)args.out, (bf16_t*)args.out + (size_t)MTOK * DM,
                         (const float*)(ws + WS_MISC) + MI_BPERM, args.in[7], (float*)(ws + WS_SB), 4096, lds + 131072};
        pg8::gemm_phase<pg8::EpiInProj, true, true>(lds, g, S, E);
    } SEAM(2);
    if (IN(3)) { p3_scan(args, lds, tid, lane, wave, vcu, G); } SEAM(3);
    if (IN(4)) { p4_mlstm_out(args, lds, tid, lane, wave, vcu, G); } SEAM(4);
    if (IN(5)) {
        pg8::Gemm g{(const bf16_t*)(ws + WS_HAB), (const bf16_t*)(ws + WS_WAB), MTOK, DM, DM, 64, 64, 32 * 32768, 0, 32768, 64 * 32768, 32 * 32768, 32768, 64 * 32768};
        pg8::MergeOrder S; S.so.init(MTOK, DM, G, bx);
        pg8::EpiMerge E{(const bf16_t*)args.out, (const bf16_t*)args.out + (size_t)MTOK * DM, (bf16_t*)(ws + WS_MG)};
        pg8::gemm_phase<pg8::EpiMerge, true, true, pg8::MergeOrder>(lds, g, S, E);
    } SEAM(5);
    if (IN(6)) {
        pg8::Gemm g{(const bf16_t*)(ws + WS_MG), (const bf16_t*)(ws + WS_WOS), MTOK, DM, DM, 64, 64, 0, DM * DM * 2, 32768, 32 * 32768, 0, 32768, 32 * 32768};
        pg8::PanelOrder S{vcu};
        pg8::EpiOutNorm E{args.in[0], (const float*)(ws + WS_CTL) + CW_MOD + 4096, args.in[12], args.out, (float*)(ws + WS_CTL) + CW_ROWSS, (unsigned*)(ws + WS_CTL) + CW_CNT};
        pg8::gemm_phase<pg8::EpiOutNorm, true, true, pg8::PanelOrder>(lds, g, S, E);
    }
#undef IN
#undef SEAM
}

extern "C" void kernel_launch(void* const* d_in, const int* in_sizes, int n_in, void* d_out, int out_size, void* d_ws, size_t ws_size, hipStream_t stream) {
    static int grid = 0;
    if (grid == 0) {
        if (n_in != 13 || out_size != MTOK * DM || ws_size < WS_END) { fprintf(stderr, "kernel_launch: unexpected problem (n_in %d, out %d, ws %zu)\n", n_in, out_size, ws_size); grid = -1; return; }
        int dev = 0, cus = 0, per_cu = 0;
        if (hipGetDevice(&dev) != hipSuccess || hipDeviceGetAttribute(&cus, hipDeviceAttributeMultiprocessorCount, dev) != hipSuccess) { grid = -1; return; }
        if (hipFuncSetAttribute((const void*)fwd_kernel, hipFuncAttributeMaxDynamicSharedMemorySize, LDS_BYTES) != hipSuccess) { fprintf(stderr, "kernel_launch: hipFuncSetAttribute failed\n"); grid = -1; return; }
        if (hipOccupancyMaxActiveBlocksPerMultiprocessor(&per_cu, (const void*)fwd_kernel, NWAVES * 64, LDS_BYTES) != hipSuccess || per_cu < 1) { fprintf(stderr, "kernel_launch: occupancy query says %d blocks per CU\n", per_cu); }
        (void)hipGetLastError();
        grid = cus;
        if (grid != 256) fprintf(stderr, "kernel_launch: %d CUs; the phase program is laid out for 256\n", grid);
    }
    if (grid < 0) return;
    (void)hipMemsetAsync((char*)d_ws + WS_CTL, 0, CTL_ZERO_BYTES, stream);
    Args a{};
    for (int i = 0; i < 13; ++i) a.in[i] = (const float*)d_in[i];
    a.out = (float*)d_out; a.ws = (unsigned char*)d_ws;
#ifdef PROF_SEQ
    if (true) {
        const int seq[][2] = PROF_SEQ;
        for (unsigned i = 0; i < sizeof(seq) / sizeof(seq[0]); ++i) { a.ph_lo = seq[i][0]; a.ph_hi = seq[i][1]; a.li = i; hipLaunchKernelGGL(fwd_kernel, dim3(grid), dim3(NWAVES * 64), LDS_BYTES, stream, a); }
    } else
#endif
    if (MK_N_LAUNCHES == 1) {
        a.ph_lo = 0; a.ph_hi = N_PHASES; a.li = 0;
        hipLaunchKernelGGL(fwd_kernel, dim3(grid), dim3(NWAVES * 64), LDS_BYTES, stream, a);
    } else {
        for (int p = 0; p < N_PHASES; ++p) { a.ph_lo = p; a.ph_hi = p + 1; a.li = p; hipLaunchKernelGGL(fwd_kernel, dim3(grid), dim3(NWAVES * 64), LDS_BYTES, stream, a); }
    }
}
```

```cpp
#include <hip/hip_runtime.h>
#include <cstdio>
#include <cstdint>

#ifndef MK_N_LAUNCHES
#define MK_N_LAUNCHES 1
#endif

#define LAS __attribute__((address_space(3)))
typedef unsigned short bf16_t;
typedef short bf16x8 __attribute__((ext_vector_type(8)));
typedef short s16x4 __attribute__((ext_vector_type(4)));
typedef float f32x2 __attribute__((ext_vector_type(2)));
typedef float f32x4 __attribute__((ext_vector_type(4)));
typedef float f32x16 __attribute__((ext_vector_type(16)));
typedef unsigned u32x2 __attribute__((ext_vector_type(2)));
typedef unsigned u32x4 __attribute__((ext_vector_type(4)));
#ifndef USE_FP16
#define USE_FP16 0
#endif
#if USE_FP16
typedef _Float16 h2_t __attribute__((ext_vector_type(2)));
typedef _Float16 h8_t __attribute__((ext_vector_type(8)));
#define ONES16 0x3c003c00u
#define MFMA16(a, b, c) __builtin_amdgcn_mfma_f32_16x16x32_f16(__builtin_bit_cast(h8_t, a), __builtin_bit_cast(h8_t, b), c, 0, 0, 0)
#define MFMA32(a, b, c) __builtin_amdgcn_mfma_f32_32x32x16_f16(__builtin_bit_cast(h8_t, a), __builtin_bit_cast(h8_t, b), c, 0, 0, 0)
#else
typedef __bf16 h2_t __attribute__((ext_vector_type(2)));
#define ONES16 0x3f803f80u
#define MFMA16(a, b, c) __builtin_amdgcn_mfma_f32_16x16x32_bf16(a, b, c, 0, 0, 0)
#define MFMA32(a, b, c) __builtin_amdgcn_mfma_f32_32x32x16_bf16(a, b, c, 0, 0, 0)
#endif

constexpr int NB = 4, SEQ = 4096, DM = 2048, MTOK = NB * SEQ;
constexpr int NH = 8, DK = 128, DV = 256, CH = 64, NCH = SEQ / CH;
constexpr int INW = 20496, NPRJ = 20480;
constexpr int O_IF = 8192;
constexpr float EPS = 1e-6f;

__device__ __forceinline__ unsigned pk_bf16(float lo, float hi) { f32x2 v = {lo, hi}; h2_t b = __builtin_convertvector(v, h2_t); return __builtin_bit_cast(unsigned, b); }
#if USE_FP16
__device__ __forceinline__ float bf_lo(unsigned u) { return (float)__builtin_bit_cast(h2_t, u)[0]; }
__device__ __forceinline__ float bf_hi(unsigned u) { return (float)__builtin_bit_cast(h2_t, u)[1]; }
#else
__device__ __forceinline__ float bf_lo(unsigned u) { return __uint_as_float(u << 16); }
__device__ __forceinline__ float bf_hi(unsigned u) { return __uint_as_float(u & 0xffff0000u); }
#endif
__device__ __forceinline__ float sigmoid_f(float x) { return __builtin_amdgcn_rcpf(1.f + __builtin_amdgcn_exp2f(x * -1.4426950408889634f)); }
__device__ __forceinline__ float silu_f(float x) { return x * sigmoid_f(x); }
__device__ __forceinline__ float silu_acc(float x) { return x / (1.f + expf(-x)); }
__device__ __forceinline__ float wave_sum(float v) {
#pragma unroll
    for (int o = 1; o < 64; o <<= 1) v += __shfl_xor(v, o);
    return v;
}

__device__ __forceinline__ int win_src_col(int np) {
    const int pn = np >> 8, jc = np & 255;
    if (pn < 32) return np;
    if (pn < 64) {
        const int c = pn - 32, bj = jc >> 7, wc = (jc >> 5) & 3, fq = (jc >> 3) & 3, n = (jc >> 2) & 1, e = jc & 3;
        return 8208 + 2048 * (2 * bj + n) + 64 * c + 16 * wc + 4 * fq + e;
    }
    return ((jc >> 7) ? 18448 : 16400) + 128 * (pn - 64) + (jc & 127);
}

namespace pg8 {
constexpr int BM = 256, BK = 64, HALF = 128, HTB = HALF * BK * 2, STAGE_BYTES = 8 * HTB, NXCD = 8, WGM = 8;
__host__ __device__ __forceinline__ int lds_byte(int r, int c) { const int st = (r >> 4) * 2 + (c >> 5), rr = r & 15, cc = c & 31, ob = rr * 64 + cc * 2; return st * 1024 + (ob ^ (((ob >> 9) & 1) << 5)); }
__host__ __device__ __forceinline__ void stage_rc(int b, int& R, int& C) { const int st = b / 1024, sb = b % 1024, swz = sb ^ (((sb >> 9) & 1) << 5); R = (st >> 1) * 16 + swz / 64; C = (st & 1) * 32 + (swz % 64) / 2; }
__host__ __device__ __forceinline__ int perm32(int rho) { const int n = rho >> 4, i = rho & 15; return 8 * (i >> 2) + 4 * n + (i & 3); }

__device__ __forceinline__ float ror8(float x) { return __int_as_float(__builtin_amdgcn_update_dpp(0, __float_as_int(x), 0x128, 0xf, 0xf, false)); }
__device__ __forceinline__ f32x4 ror8(f32x4 v) { return (f32x4){ror8(v[0]), ror8(v[1]), ror8(v[2]), ror8(v[3])}; }
__host__ __device__ __forceinline__ size_t ktm(size_t row, int col, int nkt) { return (row >> 8) * ((size_t)nkt * 16384) + (size_t)(col >> 6) * 16384 + (row & 255) * 64 + (size_t)(col & 63); }
struct Unit { int pm, pn, which, par; };
struct Gemm { const bf16_t* A; const bf16_t* Bt; int M, N, K, lda, ldb, koff, bb, ksA, tsA, koffA, ksB, tsB; };

struct StaticOrder {
    int nM, nN, nwg, G, c;
    __device__ void init(int M, int N, int G_, int c_) { nM = M / BM; nN = N / BM; nwg = nM * nN; G = G_; c = c_; }
    __device__ bool next(int i, Unit& u) const {
        const long L = (long)i * G + c; if (L >= nwg) return false;
        int wgid = (int)L; { const int q = nwg / NXCD, r = nwg % NXCD, xcd = wgid % NXCD, off = wgid / NXCD; wgid = (xcd < r ? xcd * (q + 1) : r * (q + 1) + (xcd - r) * q) + off; }
        const int nig = WGM * nN, gid = wgid / nig, fm = gid * WGM, gsz = (nM - fm) < WGM ? (nM - fm) : WGM;
        u.pm = fm + ((wgid % nig) % gsz); u.pn = (wgid % nig) / gsz; u.which = 0; return true;
    }
};

template <class Epi, bool ALIGN_EPI, bool SP2, class Sched = StaticOrder>
__device__ __forceinline__ void gemm_phase(LAS unsigned char* lds, const Gemm g, const Sched& S, const Epi& E) {
    int tid = threadIdx.x; asm volatile("" : "+v"(tid));
    const int wid = __builtin_amdgcn_readfirstlane(tid >> 6), lane = tid & 63, wr = wid >> 2, wc = wid & 3, fr = lane & 15, fq = lane >> 4;
    const int K = g.K, nt = K / BK;
    unsigned voffA[2], voffB[2];
#pragma unroll
    for (int i = 0; i < 2; ++i) { int R, C; stage_rc(tid * 16 + i * 8192, R, C); const int Rb = Epi::PERM ? ((R & ~31) + perm32(R & 31)) : R;
        voffA[i] = (unsigned)(R * g.lda + C) * 2u; voffB[i] = (unsigned)(Rb * g.ldb + C) * 2u; }
    const size_t kstep = (size_t)g.ksB;
    const size_t hstepA = (size_t)HALF * g.lda * 2, hstepB = (size_t)HALF * g.ldb * 2;
    const size_t tstepA = (size_t)g.tsA, tstepB = (size_t)g.tsB, kstepA = (size_t)g.ksA;
    const unsigned ldsw = (unsigned)wid * 1024u;
    const int aoff = lds_byte(wr * 64 + fr, fq * 8), boff = lds_byte(wc * 32 + fr, fq * 8);
#define PG8_SA(b, h) (((b) * 2 + (h)) * HTB)
#define PG8_SB(b, h) ((4 + (b) * 2 + (h)) * HTB)
#define PG8_STAGE(bufoff, gbase, voff) do { const char* _gb = (const char*)(gbase); if constexpr (Epi::KHOOK) asm volatile("" : "+s"(_gb)); _Pragma("unroll") for (int _i = 0; _i < 2; ++_i) \
        __builtin_amdgcn_global_load_lds((const unsigned*)(_gb + (voff)[_i]), (LAS unsigned*)(lds + (bufoff) + ldsw + _i * 8192), 16, 0, 0); } while (0)
#define PG8_LDA(dst, b, h) do { _Pragma("unroll") for (int m = 0; m < 4; ++m) _Pragma("unroll") for (int k = 0; k < 2; ++k) dst[m][k] = *(const LAS bf16x8*)(lds + PG8_SA(b, h) + aoff + m * 2048 + k * 1024); } while (0)
#define PG8_LDB(dst, b, h) do { _Pragma("unroll") for (int n = 0; n < 2; ++n) _Pragma("unroll") for (int k = 0; k < 2; ++k) dst[n][k] = *(const LAS bf16x8*)(lds + PG8_SB(b, h) + boff + n * 2048 + k * 1024); } while (0)
#define PG8_MMA(ai, bj, At, Bt) do { __builtin_amdgcn_s_setprio(1); _Pragma("unroll") for (int m = 0; m < 4; ++m) _Pragma("unroll") for (int n = 0; n < 2; ++n) _Pragma("unroll") for (int k = 0; k < 2; ++k) \
        acc[ai][bj][m][n] = MFMA16(Bt[n][k], At[m][k], acc[ai][bj][m][n]); __builtin_amdgcn_s_setprio(0); } while (0)
#define PG8_WAIT_V(n) asm volatile("s_waitcnt vmcnt(" #n ")" ::: "memory")
#define PG8_WAIT_L(n) asm volatile("s_waitcnt lgkmcnt(" #n ")" ::: "memory")
#define PG8_BAR __builtin_amdgcn_s_barrier()
#define PG8_SCHED __builtin_amdgcn_sched_barrier(0)
    Unit cur, nxt; int ui = 0;
    if (!S.next(0, cur)) return;
    cur.par = 0;
    f32x4 acc[2][2][4][2];
#pragma unroll
    for (int a = 0; a < 2; ++a)
#pragma unroll
        for (int b = 0; b < 2; ++b)
#pragma unroll
            for (int m = 0; m < 4; ++m)
#pragma unroll
                for (int n = 0; n < 2; ++n) acc[a][b][m][n] = (f32x4){0.f, 0.f, 0.f, 0.f};
    bf16x8 At[4][2], B0[2][2], B1[2][2];
    const char* cA = (const char*)g.A + (size_t)cur.pm * tstepA + (size_t)cur.which * g.koffA; const char* cB = (const char*)g.Bt + (size_t)cur.pn * tstepB + (size_t)cur.which * g.koff + (size_t)(cur.pm >> 4) * g.bb;
    const float* hkb = nullptr; unsigned hkoffA = 0, hkoffB = 0; f32x4 hx0, hx1;
    if constexpr (Epi::KHOOK) {
        hkb = E.hook_base(cur);
        hkoffA = (unsigned)(((wr * 64 + (fr & 7)) * g.N + wc * 32 + 4 * fq + (fr < 8 ? 0 : 16)) * 4); hkoffB = (unsigned)(((wr * 64 + 8 + (fr & 7)) * g.N + wc * 32 + 4 * fq + (fr < 8 ? 16 : 0)) * 4);
    }
    if constexpr (Epi::LDS_CONST) { if (wid == 0) E.stage_consts(cur, lds, lane); }
    if constexpr (SP2) {
        PG8_STAGE(PG8_SB(0, 0), cB, voffB); PG8_STAGE(PG8_SB(0, 1), cB + hstepB, voffB); PG8_STAGE(PG8_SA(0, 0), cA, voffA); PG8_STAGE(PG8_SA(0, 1), cA + hstepA, voffA);
        if (wr == 1) PG8_BAR;
        PG8_WAIT_V(2); PG8_BAR;
        PG8_STAGE(PG8_SB(1, 0), cB + kstep, voffB); PG8_STAGE(PG8_SA(1, 0), cA + kstepA, voffA); PG8_STAGE(PG8_SB(1, 1), cB + hstepB + kstep, voffB);
        PG8_WAIT_V(6); PG8_BAR;
    } else {
        PG8_STAGE(PG8_SB(0, 0), cB, voffB); PG8_STAGE(PG8_SA(0, 0), cA, voffA); PG8_STAGE(PG8_SB(0, 1), cB + hstepB, voffB); PG8_STAGE(PG8_SA(0, 1), cA + hstepA, voffA);
        if (wr == 1) PG8_BAR;
        PG8_WAIT_V(4); PG8_BAR;
        PG8_STAGE(PG8_SB(1, 0), cB + kstep, voffB); PG8_STAGE(PG8_SA(1, 0), cA + kstepA, voffA); PG8_STAGE(PG8_SB(1, 1), cB + hstepB + kstep, voffB);
        PG8_WAIT_V(6); PG8_BAR;
    }
    for (;;) {
        const bool has_next = S.next(ui + 1, nxt); nxt.par = (ui + 1) & 1;
        const char* nA = has_next ? (const char*)g.A + (size_t)nxt.pm * tstepA + (size_t)nxt.which * g.koffA : cA; const char* nB = has_next ? (const char*)g.Bt + (size_t)nxt.pn * tstepB + (size_t)nxt.which * g.koff + (size_t)(nxt.pm >> 4) * g.bb : cB;
        for (int t0 = 0; t0 < nt; t0 += (Epi::KHOOK ? 8 : 2)) {
#pragma unroll
          for (int hu = 0; hu < (Epi::KHOOK ? 4 : 1); ++hu) {
            const int t = t0 + 2 * hu;
            const bool last = (t == nt - 2);
            const char* a1 = cA + (size_t)(t + 1) * kstepA;
            const char* a2 = last ? nA : cA + (size_t)(t + 2) * kstepA; const char* b2 = last ? nB : cB + (size_t)(t + 2) * kstep;
            const char* a3 = a2 + kstepA; const char* b3 = b2 + kstep;
            if constexpr (SP2) {
            PG8_LDB(B0, 0, 0); PG8_LDB(B1, 0, 1); PG8_SCHED; PG8_LDA(At, 0, 0); PG8_STAGE(PG8_SA(1, 1), a1 + hstepA, voffA);
            if constexpr (Epi::KHOOK) {
                const int hq = t0 >> 3; const float* hp = hkb + (size_t)((hq >> 1) * HALF + hu * 16) * g.N + (hq & 1) * HALF;
                asm volatile("global_load_dwordx4 %0, %1, %2" : "=&v"(hx0) : "v"(hkoffA), "s"(hp) : "memory");
                asm volatile("global_load_dwordx4 %0, %1, %2" : "=&v"(hx1) : "v"(hkoffB), "s"(hp) : "memory");
                PG8_WAIT_V(10);
            } else { PG8_WAIT_V(8); }
            PG8_WAIT_L(0); PG8_BAR; PG8_MMA(0, 0, At, B0); PG8_MMA(0, 1, At, B1); PG8_BAR; PG8_SCHED;
            PG8_LDA(At, 0, 1); PG8_STAGE(PG8_SB(0, 0), b2, voffB); PG8_STAGE(PG8_SB(0, 1), b2 + hstepB, voffB); PG8_STAGE(PG8_SA(0, 0), a2, voffA);
            if constexpr (Epi::KHOOK) { PG8_WAIT_V(10); } else { PG8_WAIT_V(8); }
            PG8_WAIT_L(0); PG8_BAR; PG8_MMA(1, 0, At, B0); PG8_MMA(1, 1, At, B1); PG8_BAR; PG8_SCHED;
            PG8_LDB(B0, 1, 0); PG8_LDB(B1, 1, 1); PG8_SCHED; PG8_LDA(At, 1, 0); PG8_STAGE(PG8_SA(0, 1), a2 + hstepA, voffA);
            PG8_WAIT_V(8); PG8_WAIT_L(0); PG8_BAR; PG8_MMA(0, 0, At, B0); PG8_MMA(0, 1, At, B1); PG8_BAR; PG8_SCHED;
            if constexpr (Epi::KHOOK) {
                const int hq = t0 >> 3;
                const bool lo8 = fr < 8;
                f32x4 own0, oth;
#pragma unroll
                for (int e = 0; e < 4; ++e) { own0[e] = lo8 ? hx0[e] : hx1[e]; oth[e] = lo8 ? hx1[e] : hx0[e]; }
                const f32x4 own1 = ror8(oth);
#pragma unroll
                for (int q = 0; q < 4; ++q) { const float sel = (hq == q) ? 1.f : 0.f;
                    acc[q >> 1][q & 1][hu][0] += own0 * sel; acc[q >> 1][q & 1][hu][1] += own1 * sel; }
                PG8_SCHED;
            }
            PG8_LDA(At, 1, 1); PG8_STAGE(PG8_SB(1, 0), b3, voffB); PG8_STAGE(PG8_SB(1, 1), b3 + hstepB, voffB); PG8_STAGE(PG8_SA(1, 0), a3, voffA);
            PG8_WAIT_V(8); PG8_WAIT_L(0); PG8_BAR; PG8_MMA(1, 0, At, B0); PG8_MMA(1, 1, At, B1); PG8_BAR; PG8_SCHED;
            } else {
            PG8_LDB(B0, 0, 0); PG8_SCHED; PG8_LDA(At, 0, 0); PG8_STAGE(PG8_SA(1, 1), a1 + hstepA, voffA);
            PG8_WAIT_L(8); PG8_BAR; PG8_WAIT_L(0); PG8_MMA(0, 0, At, B0); PG8_BAR; PG8_SCHED;
            PG8_LDB(B1, 0, 1); PG8_STAGE(PG8_SB(0, 0), b2, voffB);
            PG8_BAR; PG8_WAIT_L(0); PG8_MMA(0, 1, At, B1); PG8_BAR;
            PG8_LDA(At, 0, 1); PG8_STAGE(PG8_SA(0, 0), a2, voffA);
            PG8_BAR; PG8_WAIT_L(0); PG8_MMA(1, 0, At, B0); PG8_BAR; PG8_SCHED;
            PG8_STAGE(PG8_SB(0, 1), b2 + hstepB, voffB);
            PG8_WAIT_V(6); PG8_BAR; PG8_MMA(1, 1, At, B1); PG8_BAR;
            PG8_LDB(B0, 1, 0); PG8_SCHED; PG8_LDA(At, 1, 0); PG8_STAGE(PG8_SA(0, 1), a2 + hstepA, voffA);
            PG8_WAIT_L(8); PG8_BAR; PG8_WAIT_L(0); PG8_MMA(0, 0, At, B0); PG8_BAR; PG8_SCHED;
            PG8_LDB(B1, 1, 1); PG8_STAGE(PG8_SB(1, 0), b3, voffB);
            PG8_BAR; PG8_WAIT_L(0); PG8_MMA(0, 1, At, B1); PG8_BAR;
            PG8_LDA(At, 1, 1); PG8_STAGE(PG8_SA(1, 0), a3, voffA);
            PG8_BAR; PG8_WAIT_L(0); PG8_MMA(1, 0, At, B0); PG8_BAR; PG8_SCHED;
            PG8_STAGE(PG8_SB(1, 1), b3 + hstepB, voffB);
            PG8_WAIT_V(6); PG8_BAR; PG8_MMA(1, 1, At, B1); PG8_BAR;
            }
          }
        }
        if constexpr (ALIGN_EPI) { if (wr == 0) PG8_BAR; }
        E(acc, cur, wr, wc, fr, fq);
        if (!has_next) break;
        if (!Epi::keeps_acc(cur)) {
#pragma unroll
        for (int a = 0; a < 2; ++a)
#pragma unroll
            for (int b = 0; b < 2; ++b)
#pragma unroll
                for (int m = 0; m < 4; ++m)
#pragma unroll
                    for (int n = 0; n < 2; ++n) acc[a][b][m][n] = (f32x4){0.f, 0.f, 0.f, 0.f};
        }
        cur = nxt; cA = nA; cB = nB; ++ui;
        if constexpr (Epi::KHOOK) hkb = E.hook_base(cur);
        if constexpr (Epi::LDS_CONST) { if (wid == 0) E.stage_consts(cur, lds, lane); }
        if constexpr (ALIGN_EPI) { if (wr == 1) PG8_BAR; }
    }
    PG8_WAIT_V(0);
    if constexpr (!ALIGN_EPI) { if (wr == 0) PG8_BAR; }
    PG8_BAR;
#undef PG8_SA
#undef PG8_SB
#undef PG8_STAGE
#undef PG8_LDA
#undef PG8_LDB
#undef PG8_MMA
#undef PG8_WAIT_V
#undef PG8_WAIT_L
#undef PG8_BAR
#undef PG8_SCHED
}


struct EpiInProj {
    static __device__ __forceinline__ bool keeps_acc(const Unit&) { return false; }
    static constexpr bool PERM = true; static constexpr bool LDS_CONST = true; static constexpr bool KHOOK = false;
    bf16_t *Q, *Kr, *KT, *VT, *OG, *ZA, *HB, *GA, *GB; const float* bias; const float* convw; float* SB; int ldhb; LAS unsigned char* tlds;
    __device__ __forceinline__ void stage_consts(const Unit& u, LAS unsigned char* lds, int lane) const {
        LAS unsigned char* cb = tlds + 9216 + 2048 * u.par;
        __builtin_amdgcn_global_load_lds((const unsigned*)(bias + u.pn * BM + 4 * lane), (LAS unsigned*)cb, 16, 0, 0);
        if (u.pn >= 32 && u.pn < 64) {
#pragma unroll
            for (int tap = 0; tap < 3; ++tap) __builtin_amdgcn_global_load_lds((const unsigned*)(convw + tap * 2048 + 64 * (u.pn - 32) + lane), (LAS unsigned*)(cb + 1024 + 256 * tap), 4, 0, 0);
        }
        (void)lds;
    }
    __device__ __forceinline__ void operator()(f32x4 (&acc)[2][2][4][2], const Unit& u, int wr, int wc, int fr, int fq) const {
        const int pn = u.pn;
        const LAS float* cbias = (const LAS float*)(tlds + 9216 + 2048 * u.par) + wc * 32 + 8 * fq;
        const LAS float* ctap = (const LAS float*)(tlds + 9216 + 2048 * u.par + 1024) + 16 * wc + 4 * fq;
        const int row0 = u.pm * BM + wr * 64 + fr;
        const int bcol0 = pn * BM + wc * 32 + 8 * fq;
        if (pn >= 32 && pn < 64) {
            const int ch0 = 64 * (pn - 32) + 16 * wc + 4 * fq;
            const f32x4 w0 = *(const LAS f32x4*)(ctap), w1 = *(const LAS f32x4*)(ctap + 64), w2 = *(const LAS f32x4*)(ctap + 128);
            const f32x4 bu = *(const LAS f32x4*)(cbias), bB = *(const LAS f32x4*)(cbias + 4), bC = *(const LAS f32x4*)(cbias + HALF), bz = *(const LAS f32x4*)(cbias + HALF + 4);
            const int lane = fq * 16 + fr;
#pragma unroll
            for (int ai = 0; ai < 2; ++ai) {
                f32x4 pr1 = (f32x4){0.f, 0.f, 0.f, 0.f}, pr2 = pr1;
                const int g = u.pm * 4 + ai * 2 + wr;
                float* sb = SB + (size_t)g * 6 * 2048 + ch0;
#pragma unroll
                for (int m = 0; m < 4; ++m) {
                    const f32x4 uu = acc[ai][0][m][0] + bu, Bv = acc[ai][0][m][1] + bB, Cv = acc[ai][1][m][0] + bC, zb = acc[ai][1][m][1] + bz;
                    f32x4 cu, bzv, r1, r2, p1, p2, hb;
#pragma unroll
                    for (int e = 0; e < 4; ++e) { cu[e] = Cv[e] * uu[e]; bzv[e] = Bv[e] * silu_f(zb[e]); }
#pragma unroll
                    for (int e = 0; e < 4; ++e) { r1[e] = __int_as_float(__builtin_amdgcn_update_dpp(0, __float_as_int(cu[e]), 0x121, 0xf, 0xf, false)); r2[e] = __int_as_float(__builtin_amdgcn_update_dpp(0, __float_as_int(cu[e]), 0x122, 0xf, 0xf, false)); }
#pragma unroll
                    for (int e = 0; e < 4; ++e) { p1[e] = fr >= 1 ? r1[e] : pr1[e]; p2[e] = fr >= 2 ? r2[e] : pr2[e]; }
                    const f32x4 cv = w0 * p2 + w1 * p1 + w2 * cu;
                    hb = bzv * cv;
                    u32x2 w; w.x = pk_bf16(hb[0], hb[1]); w.y = pk_bf16(hb[2], hb[3]);
                    *(u32x2*)(HB + ktm((size_t)(row0 + ai * HALF + m * 16), 2048 + ch0, 64)) = w;
                    if (m == 0 && fr < 2) { *(f32x4*)(sb + (2 + fr) * 2048) = bzv; *(f32x4*)(sb + (4 + fr) * 2048) = cv; }
                    if (m == 3 && fr >= 14) { *(f32x4*)(sb + (fr - 14) * 2048) = cu; }
                    pr1 = r1; pr2 = r2;
                }
            }
            return;
        }
        int kind, colt, act = 0; float sc = 1.f; bf16_t* dst = nullptr; bf16_t* dstT = nullptr;
        if (pn < 4) { kind = 0; dst = Q; colt = pn * BM; sc = 0.08838834764831845f; }
        else if (pn < 8) { kind = 1; dst = Kr; dstT = KT; colt = (pn - 4) * BM; }
        else if (pn < 16) { kind = 2; dstT = VT; colt = (pn - 8) * BM; }
        else if (pn < 24) { kind = 3; dst = OG; colt = (pn - 16) * BM; act = 1; }
        else if (pn < 32) { kind = 4; dst = ZA; colt = (pn - 24) * BM; act = 2; }
        else {
            const int ch0 = 128 * (pn - 64) + wc * 32 + 8 * fq;
            f32x4 ba[2], bb[2];
#pragma unroll
            for (int n = 0; n < 2; ++n) { ba[n] = *(const LAS f32x4*)(cbias + 4 * n); bb[n] = *(const LAS f32x4*)(cbias + HALF + 4 * n); }
#pragma unroll
            for (int ai = 0; ai < 2; ++ai)
#pragma unroll
                for (int m = 0; m < 4; ++m) {
                    const size_t off = ((((((size_t)(u.pm * 2 + ai) * 2 + wr) * 4 + m) * 16 + (pn - 64)) * 4 + wc) * 64 + fq * 16 + fr) * 8;
                    float rr[8], gg[8];
#pragma unroll
                    for (int n = 0; n < 2; ++n)
#pragma unroll
                        for (int e = 0; e < 4; ++e) {
                            const float ea = __builtin_amdgcn_exp2f((acc[ai][0][m][n][e] + ba[n][e]) * -1.4426950408889634f), eb = __builtin_amdgcn_exp2f((acc[ai][1][m][n][e] + bb[n][e]) * -1.4426950408889634f);
                            rr[4 * n + e] = (1.f + eb) * __builtin_amdgcn_rcpf(1.f + ea); gg[4 * n + e] = __builtin_amdgcn_rcpf(1.f + eb);
                        }
                    u32x4 wr_, wg_;
                    wr_.x = pk_bf16(rr[0], rr[1]); wr_.y = pk_bf16(rr[2], rr[3]); wr_.z = pk_bf16(rr[4], rr[5]); wr_.w = pk_bf16(rr[6], rr[7]);
                    wg_.x = pk_bf16(gg[0], gg[1]); wg_.y = pk_bf16(gg[2], gg[3]); wg_.z = pk_bf16(gg[4], gg[5]); wg_.w = pk_bf16(gg[6], gg[7]);
                    *(u32x4*)(GA + off) = wr_; *(u32x4*)(GB + off) = wg_;
                }
            return;
        }
        const int col0 = colt + wc * 32 + 8 * fq;
        f32x4 bv[2][2];
#pragma unroll
        for (int bj = 0; bj < 2; ++bj)
#pragma unroll
            for (int n = 0; n < 2; ++n) bv[bj][n] = *(const LAS f32x4*)(cbias + bj * HALF + 4 * n);
        if (kind != 2) {
#pragma unroll
        for (int ai = 0; ai < 2; ++ai)
#pragma unroll
            for (int m = 0; m < 4; ++m) {
                const int row = row0 + ai * HALF + m * 16;
                const int cidx = row >> 6, tau = row & 63;
#pragma unroll
                for (int bj = 0; bj < 2; ++bj) {
                    f32x4 v0 = acc[ai][bj][m][0] + bv[bj][0], v1 = acc[ai][bj][m][1] + bv[bj][1];
                    if (act == 1) {
#pragma unroll
                        for (int e = 0; e < 4; ++e) { v0[e] = sigmoid_f(v0[e]); v1[e] = sigmoid_f(v1[e]); }
                    } else if (act == 2) {
#pragma unroll
                        for (int e = 0; e < 4; ++e) { v0[e] = silu_f(v0[e]); v1[e] = silu_f(v1[e]); }
                    } else { v0 = v0 * sc; v1 = v1 * sc; }
                    u32x4 w; w.x = pk_bf16(v0[0], v0[1]); w.y = pk_bf16(v0[2], v0[3]); w.z = pk_bf16(v1[0], v1[1]); w.w = pk_bf16(v1[2], v1[3]);
                    const int c0 = col0 + bj * HALF;
                    if (kind <= 1) {
                        const int hh = c0 >> 7, dk0 = c0 & 127;
                        const size_t fi = ((((size_t)((cidx >> 6) * 8 + hh) * 64 + (cidx & 63)) * 2 + (tau >> 5)) * 8 + (dk0 >> 4)) * 64 + ((dk0 >> 3) & 1) * 32 + (tau & 31);
                        *(u32x4*)(dst + fi * 8) = w;
                    } else {
                        const int hh = c0 >> 8, d8 = (c0 & 255) >> 3;
                        const size_t fi = ((((size_t)((cidx >> 6) * 8 + hh) * 64 + (cidx & 63)) * 2 + (tau >> 5)) * 32 + d8) * 64 + (tau & 31);
                        *(u32x2*)(dst + fi * 4) = (u32x2){w.x, w.y}; *(u32x2*)(dst + (fi + 32) * 4) = (u32x2){w.z, w.w};
                    }
                }
            }
        }
        if (kind == 1 || kind == 2) {
            const int hshift = kind == 1 ? 7 : 8, nblk = kind == 1 ? 4 : 8;
            const int lane = fq * 16 + fr;
            LAS unsigned char* my = tlds + (wr * 4 + wc) * 1152;
            LAS unsigned char* wp = my + (4 * fq) * 72 + fr * 2;
            const LAS unsigned char* rp = my + (lane >> 2) * 72 + ((lane >> 1) & 1) * 32 + (lane & 1) * 8;
            const int ccol0 = colt + wc * 32 + 8 * (lane >> 4) + ((lane >> 2) & 3);
            const int rrow0 = u.pm * BM + wr * 64;
#pragma unroll
            for (int ai = 0; ai < 2; ++ai)
#pragma unroll
                for (int bj = 0; bj < 2; ++bj)
#pragma unroll
                    for (int n = 0; n < 2; ++n)
#pragma unroll
                        for (int mp = 0; mp < 2; ++mp) {
#pragma unroll
                            for (int mm = 0; mm < 2; ++mm) {
                                const f32x4 v = acc[ai][bj][2 * mp + mm][n] + bv[bj][n];
                                const unsigned p01 = pk_bf16(v[0], v[1]), p23 = pk_bf16(v[2], v[3]);
                                *(LAS unsigned short*)(wp + 0 * 72 + 32 * mm) = (unsigned short)(p01 & 0xffffu); *(LAS unsigned short*)(wp + 1 * 72 + 32 * mm) = (unsigned short)(p01 >> 16);
                                *(LAS unsigned short*)(wp + 2 * 72 + 32 * mm) = (unsigned short)(p23 & 0xffffu); *(LAS unsigned short*)(wp + 3 * 72 + 32 * mm) = (unsigned short)(p23 >> 16);
                            }
                            asm volatile("" ::: "memory");
                            const u32x2 lo = *(const LAS u32x2*)(rp), hi = *(const LAS u32x2*)(rp + 16);
                            asm volatile("" ::: "memory");
                            const int rr = rrow0 + ai * HALF + 32 * mp, cidx = rr >> 6, ks = ((rr & 63) >> 4) + ((lane >> 1) & 1);
                            const int cc = ccol0 + bj * HALF + 4 * n, hh = cc >> hshift, rowi = cc & ((1 << hshift) - 1);
                            const size_t fi = ((((size_t)((cidx >> 6) * 8 + hh) * 64 + (cidx & 63)) * nblk + (rowi >> 5)) * 4 + ks) * 64 + (lane & 1) * 32 + (rowi & 31);
                            *(u32x4*)(dstT + fi * 8) = (u32x4){lo.x, lo.y, hi.x, hi.y};
                        }
        }
    }
};

struct MergeOrder {
    StaticOrder so;
    __device__ bool next(int i, Unit& u) const { if (!so.next(i >> 1, u)) return false; u.which = i & 1; return true; }
};
struct EpiMerge {
    static __device__ __forceinline__ bool keeps_acc(const Unit& u) { return u.which == 0; }
    static constexpr bool PERM = true; static constexpr bool LDS_CONST = false; static constexpr bool KHOOK = false;
    const bf16_t* RR; const bf16_t* GB; bf16_t* MG;
    __device__ __forceinline__ void operator()(f32x4 (&acc)[2][2][4][2], const Unit& u, int wr, int wc, int fr, int fq) const {
        const int row0 = u.pm * BM + wr * 64 + fr, col0 = u.pn * BM + wc * 32 + 8 * fq;
        const bf16_t* src = u.which == 0 ? RR : GB;
        u32x4 gv[2][4][2];
#pragma unroll
        for (int ai = 0; ai < 2; ++ai)
#pragma unroll
            for (int m = 0; m < 4; ++m)
#pragma unroll
                for (int bj = 0; bj < 2; ++bj) gv[ai][m][bj] = *(const u32x4*)(src + ((((((size_t)(u.pm * 2 + ai) * 2 + wr) * 4 + m) * 16 + (2 * u.pn + bj)) * 4 + wc) * 64 + fq * 16 + fr) * 8);
        asm volatile("" ::: "memory");
#pragma unroll
        for (int ai = 0; ai < 2; ++ai)
#pragma unroll
            for (int m = 0; m < 4; ++m) {
#pragma unroll
                for (int bj = 0; bj < 2; ++bj) {
                    const size_t off = ktm((size_t)(row0 + ai * HALF + m * 16), col0 + bj * HALF, 32);
                    const u32x4 g = gv[ai][m][bj];
                    f32x4 g0 = {bf_lo(g.x), bf_hi(g.x), bf_lo(g.y), bf_hi(g.y)}, g1 = {bf_lo(g.z), bf_hi(g.z), bf_lo(g.w), bf_hi(g.w)};
                    const f32x4 t0 = acc[ai][bj][m][0] * g0, t1 = acc[ai][bj][m][1] * g1;
                    if (u.which == 0) { acc[ai][bj][m][0] = t0; acc[ai][bj][m][1] = t1; }
                    else { u32x4 w; w.x = pk_bf16(t0[0], t0[1]); w.y = pk_bf16(t0[2], t0[3]); w.z = pk_bf16(t1[0], t1[1]); w.w = pk_bf16(t1[2], t1[3]); *(u32x4*)(MG + off) = w; }
                }
            }
    }
};
struct PanelOrder {
    int vcu;
    __device__ bool next(int i, Unit& u) const { if (i >= 2) return false; u.pm = 32 * i + (vcu >> 3); u.pn = vcu & 7; u.which = 0; return true; }
};
struct EpiOutNorm {
    static __device__ __forceinline__ bool keeps_acc(const Unit&) { return false; }
    static constexpr bool PERM = false; static constexpr bool LDS_CONST = false; static constexpr bool KHOOK = true;
    const float* X; const float* gate; const float* nfw; float* O; float* rowss; unsigned* cnt;
    __device__ __forceinline__ const float* hook_base(const Unit& u) const { return X + (size_t)(u.pm * BM) * DM + u.pn * BM; }
    __device__ __forceinline__ void operator()(f32x4 (&acc)[2][2][4][2], const Unit& u, int wr, int wc, int fr, int fq) const {
        asm volatile("" : "+v"(fr), "+v"(fq));
        const int row0 = u.pm * BM + wr * 64 + fr, col0 = u.pn * BM + wc * 32 + 4 * fq;
        float rs[2][4];
#pragma unroll
        for (int ai = 0; ai < 2; ++ai)
#pragma unroll
            for (int m = 0; m < 4; ++m) {
                float q = 0.f;
#pragma unroll
                for (int bj = 0; bj < 2; ++bj)
#pragma unroll
                    for (int n = 0; n < 2; ++n) { const f32x4 v = acc[ai][bj][m][n]; q += (v[0] * v[0] + v[1] * v[1]) + (v[2] * v[2] + v[3] * v[3]); }
                q += __shfl_xor(q, 16); q += __shfl_xor(q, 32);
                rs[ai][m] = q;
            }
        float sink = 0.f;
        if (fq == 0) {
#pragma unroll
            for (int ai = 0; ai < 2; ++ai)
#pragma unroll
                for (int m = 0; m < 4; ++m) sink += __hip_atomic_fetch_add(rowss + row0 + ai * HALF + m * 16, rs[ai][m], __ATOMIC_RELAXED, __HIP_MEMORY_SCOPE_AGENT);
        }
        asm volatile("s_waitcnt vmcnt(0)" :: "v"(sink) : "memory");
        unsigned* cp = cnt + 64 * u.pm;
        if (fq == 0 && fr == 0) (void)__hip_atomic_fetch_add(cp, 1u, __ATOMIC_RELAXED, __HIP_MEMORY_SCOPE_AGENT);
        {
            unsigned spins = 0;
            while ((unsigned)__builtin_amdgcn_readfirstlane(__hip_atomic_load(cp, __ATOMIC_RELAXED, __HIP_MEMORY_SCOPE_AGENT)) < 64u) { __builtin_amdgcn_s_sleep(2); if (++spins > (1u << 22)) break; }
        }
        asm volatile("" ::: "memory");
        float rstd[2][4];
#pragma unroll
        for (int ai = 0; ai < 2; ++ai)
#pragma unroll
            for (int m = 0; m < 4; ++m) rstd[ai][m] = rsqrtf(__hip_atomic_load(rowss + row0 + ai * HALF + m * 16, __ATOMIC_RELAXED, __HIP_MEMORY_SCOPE_AGENT) * (1.f / DM) + EPS);
        f32x4 wv[2][2];
#pragma unroll
        for (int bj = 0; bj < 2; ++bj)
#pragma unroll
            for (int n = 0; n < 2; ++n) wv[bj][n] = *(const f32x4*)(nfw + col0 + bj * HALF + n * 16);
        const bool lo8 = fr < 8;
        float* oA = O + (size_t)(u.pm * BM + wr * 64 + (fr & 7)) * DM + u.pn * BM + wc * 32 + 4 * fq + (lo8 ? 0 : 16);
        float* oB = O + (size_t)(u.pm * BM + wr * 64 + 8 + (fr & 7)) * DM + u.pn * BM + wc * 32 + 4 * fq + (lo8 ? 16 : 0);
#pragma unroll
        for (int ai = 0; ai < 2; ++ai)
#pragma unroll
            for (int m = 0; m < 4; ++m) {
                const size_t off = (size_t)(ai * HALF + m * 16) * DM;
#pragma unroll
                for (int bj = 0; bj < 2; ++bj) {
                    const f32x4 v0 = acc[ai][bj][m][0] * rstd[ai][m] * wv[bj][0], v1 = acc[ai][bj][m][1] * rstd[ai][m] * wv[bj][1];
                    const f32x4 t1 = ror8(v1);
                    f32x4 dA, dB;
#pragma unroll
                    for (int e = 0; e < 4; ++e) { dA[e] = lo8 ? v0[e] : t1[e]; dB[e] = lo8 ? t1[e] : v0[e]; }
                    *(f32x4*)(oA + off + bj * HALF) = dA; *(f32x4*)(oB + off + bj * HALF) = dB;
                }
            }
    }
};
}

constexpr size_t MiB = 1u << 20;
constexpr size_t WS_CTL = 0, CTL_ZERO_BYTES = 73728 * 4;
constexpr size_t WS_MISC = 1 * MiB;
constexpr size_t WS_WINT = 8 * MiB;
constexpr size_t WS_H = 88 * MiB;
constexpr size_t WS_CT = 8 * MiB;
constexpr size_t WS_MG = 8 * MiB;
constexpr size_t WS_WAB = 152 * MiB;
constexpr size_t WS_WO = 168 * MiB;
constexpr size_t WS_Q = 176 * MiB, WS_K = 208 * MiB, WS_VT = 240 * MiB, WS_KT = 304 * MiB;
constexpr size_t WS_OG = 336 * MiB, WS_ZA = 400 * MiB, WS_HAB = 464 * MiB;
constexpr size_t WS_SB = 592 * MiB;
constexpr size_t WS_WOS = 604 * MiB;
constexpr size_t WS_END = 636 * MiB;
constexpr int CW_BAR = 0;
constexpr int CW_MOD = 28672;
constexpr int CW_ROWSS = 53248;
constexpr int CW_CNT = 69632;
constexpr size_t MI_BPERM = 0;
constexpr size_t MI_AMX = 32768, MI_GS = MI_AMX + 4096, MI_MS = MI_GS + 4096;
constexpr size_t MI_AA = 65536, MI_CM = MI_AA + 131072, MI_BB = MI_CM + 131072;
constexpr size_t MI_NJ = MI_BB + 131072;
constexpr size_t MI_WIF = MI_NJ + 262144;
static_assert((MI_WIF + 32768) * 4 <= 7 * MiB, "misc map");

constexpr int NWAVES = 8;
constexpr int LDS_BYTES = 147456;

#define GAS __attribute__((address_space(1)))
typedef GAS unsigned gu32;
#define RLX_AGENT __ATOMIC_RELAXED, __HIP_MEMORY_SCOPE_AGENT

#define XB_TMO      128
#define XB_XCNT(j)  (256  + 64 * (j))
#define XB_XSUB(j)  (1280 + 64 * (j))
#define XB_XGEN(j)  (2304 + 64 * (j))
#define XB_TOP      3328
#define XB_TOPGEN   3392
#define XCD_BAR_WORDS 3456
#define XB_SPIN_CAP (1u << 18)
__device__ __forceinline__ unsigned xb_ld(unsigned* p)              { return __hip_atomic_load(p, __ATOMIC_RELAXED, __HIP_MEMORY_SCOPE_AGENT); }
__device__ __forceinline__ unsigned xb_add(unsigned* p, unsigned v) { return __hip_atomic_fetch_add(p, v, __ATOMIC_RELAXED, __HIP_MEMORY_SCOPE_AGENT); }
__device__ __forceinline__ unsigned xb_xcc_id() { return (unsigned)__builtin_amdgcn_s_getreg((3 << 11) | 20) & 0xFu; }
#define XB_SPIN(cond, bar) do { unsigned _sp = 0; while (cond) { __builtin_amdgcn_s_sleep(1); \
    if ((++_sp & 255u) == 0u) { if (xb_ld(&(bar)[XB_TMO])) break; if (_sp > XB_SPIN_CAP) { atomicAdd(&(bar)[XB_TMO], 1u); break; } } } } while (0)
struct XcdBarrier { unsigned* bar; unsigned x; volatile LAS unsigned* st; };
__device__ __forceinline__ XcdBarrier xcd_barrier_post(unsigned* bar, volatile LAS unsigned* st) {
    XcdBarrier b; b.bar = bar; b.x = xb_xcc_id(); b.st = st;
    if (threadIdx.x == 0) (void)xb_add(&bar[XB_XCNT(b.x)], 1u);
    return b;
}
__device__ __forceinline__ void xcd_barrier_complete(unsigned* bar, unsigned x, unsigned& nloc, unsigned& nx) {
    const unsigned G = gridDim.x * gridDim.y * gridDim.z;
    unsigned sum, cnt, mine, sp = 0u;
    for (;;) {
        sum = 0u; cnt = 0u; mine = 0u;
#pragma unroll
        for (unsigned j = 0; j < 16; ++j) { const unsigned c = xb_ld(&bar[XB_XCNT(j)]); sum += c; cnt += (c > 0u) ? 1u : 0u; mine = (j == x) ? c : mine; }
        if (sum == G) break;
        __builtin_amdgcn_s_sleep(1);
        if ((++sp & 255u) == 0u) { if (xb_ld(&bar[XB_TMO])) break; if (sp > XB_SPIN_CAP) { atomicAdd(&bar[XB_TMO], 1u); break; } }
    }
    nloc = mine > 0u ? mine : 1u; nx = cnt > 0u ? cnt : 1u;
}
__device__ __forceinline__ void xcd_barrier(const XcdBarrier& b) {
    asm volatile("s_waitcnt vmcnt(0)" ::: "memory");
    __syncthreads();
    if (threadIdx.x == 0) {
        unsigned* bar = b.bar;
        __builtin_amdgcn_s_waitcnt(0);
        unsigned nloc = b.st[0], nx = b.st[1];
        if (nloc == 0u) { xcd_barrier_complete(bar, b.x, nloc, nx); b.st[0] = nloc; b.st[1] = nx; }
        const unsigned old = xb_add(&bar[XB_XSUB(b.x)], 1u);
        const unsigned gen = old / nloc;
        if (old + 1u == (gen + 1u) * nloc) {
            __builtin_amdgcn_fence(__ATOMIC_RELEASE, "agent");
            asm volatile("s_waitcnt vmcnt(0)" ::: "memory");
            const unsigned og = xb_add(&bar[XB_TOP], 1u);
            const unsigned tg = og / nx;
            if (og + 1u == (tg + 1u) * nx) xb_add(&bar[XB_TOPGEN], 1u);
            else XB_SPIN(xb_ld(&bar[XB_TOPGEN]) == tg, bar);
            __builtin_amdgcn_fence(__ATOMIC_ACQUIRE, "agent");
            xb_add(&bar[XB_XGEN(b.x)], 1u);
            asm volatile("s_waitcnt vmcnt(0)" ::: "memory");
        } else {
            XB_SPIN(xb_ld(&bar[XB_XGEN(b.x)]) == gen, bar);
            __builtin_amdgcn_fence(__ATOMIC_ACQUIRE, "agent");
            asm volatile("s_waitcnt vmcnt(0)" ::: "memory");
        }
    }
    __syncthreads();
}

struct Args { const float* in[13]; float* out; unsigned char* ws; int ph_lo, ph_hi, li, pad; };

template <class ColFn>
__device__ __forceinline__ void p0_transpose_item(const float* W, int ldw, bf16_t* WT, int ldt, int koff, int k0, int n0, ColFn colfn, LAS float* scr, int lane) {
    const int sc = colfn(n0 + 4 * (lane & 7));
    f32x4 v[8];
#pragma unroll
    for (int i = 0; i < 8; ++i) v[i] = *(const f32x4*)(W + (size_t)(k0 + 8 * i + (lane >> 3)) * ldw + sc);
#pragma unroll
    for (int i = 0; i < 8; ++i) { LAS float* d = scr + (8 * i + (lane >> 3)) * 33 + 4 * (lane & 7); d[0] = v[i][0]; d[1] = v[i][1]; d[2] = v[i][2]; d[3] = v[i][3]; }
    asm volatile("s_waitcnt lgkmcnt(0)" ::: "memory");
    const int c = lane & 7;
#pragma unroll
    for (int j = 0; j < 4; ++j) { const int n = (lane >> 3) + 8 * j; const LAS float* s = scr + (8 * c) * 33 + n;
        u32x4 o; o.x = pk_bf16(s[0 * 33], s[1 * 33]); o.y = pk_bf16(s[2 * 33], s[3 * 33]); o.z = pk_bf16(s[4 * 33], s[5 * 33]); o.w = pk_bf16(s[6 * 33], s[7 * 33]);
        *(u32x4*)(WT + (size_t)(n0 + n) * ldt + koff + k0 + 8 * c) = o; }
    asm volatile("s_waitcnt lgkmcnt(0)" ::: "memory");
}

struct P0Item { const float* src; bf16_t* dst; int ldw, ldt; };
__device__ __forceinline__ P0Item p0_item(const Args& a, unsigned char* ws, int it, int lane) {
    constexpr int I_IN = 32 * 640, I_SQ = 32 * 64;
    P0Item p;
    if (it < I_IN) {
        const int kb = it / 640, nb = it % 640;
        p.src = a.in[5] + (size_t)(64 * kb) * INW + win_src_col(32 * nb + 4 * (lane & 7)); p.ldw = INW;
        p.dst = (bf16_t*)(ws + WS_WINT) + pg8::ktm((size_t)(32 * nb), 64 * kb, 32); p.ldt = 64;
    } else {
        const int r0 = it - I_IN, mat = r0 / I_SQ, r = r0 % I_SQ, kb = r / 64, nb = r % 64;
        const float* W = mat == 0 ? a.in[9] : a.in[10];
        p.src = W + (size_t)(64 * kb) * DM + 32 * nb + 4 * (lane & 7); p.ldw = DM;
        p.ldt = 64;
        p.dst = (bf16_t*)(ws + WS_WAB) + pg8::ktm((size_t)(32 * nb), (mat == 1 ? 2048 : 0) + 64 * kb, 64);
    }
    return p;
}
__device__ __forceinline__ void p0_item_load(const P0Item& p, f32x4 (&v)[8], int lane) {
#pragma unroll
    for (int i = 0; i < 8; ++i) v[i] = *(const f32x4*)(p.src + (size_t)(8 * i + (lane >> 3)) * p.ldw);
}
__device__ __forceinline__ void p0_item_finish(const P0Item& p, const f32x4 (&v)[8], LAS float* scr, int lane) {
#pragma unroll
    for (int i = 0; i < 8; ++i) { LAS float* d = scr + (8 * i + (lane >> 3)) * 33 + 4 * (lane & 7); d[0] = v[i][0]; d[1] = v[i][1]; d[2] = v[i][2]; d[3] = v[i][3]; }
    asm volatile("s_waitcnt lgkmcnt(0)" ::: "memory");
    const int c = lane & 7;
#pragma unroll
    for (int j = 0; j < 4; ++j) { const int n = (lane >> 3) + 8 * j; const LAS float* sp = scr + (8 * c) * 33 + n;
        u32x4 o; o.x = pk_bf16(sp[0 * 33], sp[1 * 33]); o.y = pk_bf16(sp[2 * 33], sp[3 * 33]); o.z = pk_bf16(sp[4 * 33], sp[5 * 33]); o.w = pk_bf16(sp[6 * 33], sp[7 * 33]);
        *(u32x4*)(p.dst + (size_t)n * p.ldt + 8 * c) = o; }
    asm volatile("s_waitcnt lgkmcnt(0)" ::: "memory");
}

__device__ __forceinline__ void p0_prep(const Args& a, LAS unsigned char* lds, int tid, int lane, int wave, int vcu, int G) {
    unsigned char* ws = a.ws;
    const float* c_in = a.in[1]; const float* w_ada = a.in[3]; const float* b_ada = a.in[4]; const float* w_in = a.in[5]; const float* b_in = a.in[6];
    float* MOD = (float*)(ws + WS_CTL) + CW_MOD;
    {
        const int bx = blockIdx.x, cg = bx & 7, ks = bx >> 3;
        if (ks < 32) {
            LAS float* cact = (LAS float*)(lds + 100 * 1024);
            if (tid < 256) { const int b = tid >> 6, kk = tid & 63; cact[tid] = silu_acc(c_in[b * DM + ks * 64 + kk]); }
            f32x4 wv[8][3];
#pragma unroll
            for (int kk = 0; kk < 8; ++kk)
#pragma unroll
                for (int j = 0; j < 3; ++j) wv[kk][j] = *(const f32x4*)(w_ada + (size_t)(ks * 64 + wave * 8 + kk) * 6144 + cg * 768 + 256 * j + 4 * lane);
            __syncthreads();
            f32x4 acc[4][3];
#pragma unroll
            for (int b = 0; b < 4; ++b)
#pragma unroll
                for (int j = 0; j < 3; ++j) acc[b][j] = (f32x4){0.f, 0.f, 0.f, 0.f};
#pragma unroll
            for (int kk = 0; kk < 8; ++kk) {
                float ca[4];
#pragma unroll
                for (int b = 0; b < 4; ++b) ca[b] = cact[b * 64 + wave * 8 + kk];
#pragma unroll
                for (int j = 0; j < 3; ++j)
#pragma unroll
                    for (int b = 0; b < 4; ++b) acc[b][j] += wv[kk][j] * ca[b];
            }
            LAS f32x4* red = (LAS f32x4*)lds;
#pragma unroll
            for (int b = 0; b < 4; ++b)
#pragma unroll
                for (int j = 0; j < 3; ++j) red[(wave * 12 + b * 3 + j) * 64 + lane] = acc[b][j];
            __syncthreads();
            for (int idx = tid; idx < 768; idx += 512) {
                const int bj = idx >> 6, ln = idx & 63, b = bj / 3, j = bj % 3;
                f32x4 s = (f32x4){0.f, 0.f, 0.f, 0.f};
#pragma unroll
                for (int w = 0; w < 8; ++w) s += red[(w * 12 + bj) * 64 + ln];
                const int col = cg * 768 + 256 * j + 4 * ln;
                if (ks == 0) s += *(const f32x4*)(b_ada + col);
                float* mp = MOD + b * 6144 + col;
                atomicAdd(mp + 0, s[0]); atomicAdd(mp + 1, s[1]); atomicAdd(mp + 2, s[2]); atomicAdd(mp + 3, s[3]);
            }
            __syncthreads();
        }
    }
    {
        LAS float* scr = (LAS float*)(lds + wave * 16384);
        const int gw = vcu * NWAVES + wave, NGW = G * NWAVES;
        constexpr int NITEMS = 32 * 640 + 2 * 32 * 64;
        if (NGW * 12 == NITEMS) {
            P0Item I0 = p0_item(a, ws, gw, lane), I1;
            f32x4 v0[8], v1[8];
            p0_item_load(I0, v0, lane);
#pragma unroll 1
            for (int k = 0; k < 10; k += 2) {
                I1 = p0_item(a, ws, gw + (k + 1) * NGW, lane); p0_item_load(I1, v1, lane); p0_item_finish(I0, v0, scr, lane);
                I0 = p0_item(a, ws, gw + (k + 2) * NGW, lane); p0_item_load(I0, v0, lane); p0_item_finish(I1, v1, scr, lane);
            }
            I1 = p0_item(a, ws, gw + 11 * NGW, lane); p0_item_load(I1, v1, lane); p0_item_finish(I0, v0, scr, lane);
            p0_item_finish(I1, v1, scr, lane);
        } else {
            for (int it = gw; it < NITEMS; it += NGW) { const P0Item I = p0_item(a, ws, it, lane); f32x4 v[8]; p0_item_load(I, v, lane); p0_item_finish(I, v, scr, lane); }
        }
        float* bperm = (float*)(ws + WS_MISC) + MI_BPERM;
        for (int i = blockIdx.x * 512 + tid; i < NPRJ; i += G * 512) bperm[i] = b_in[win_src_col(i)];
        float* wif = (float*)(ws + WS_MISC) + MI_WIF;
        for (int i = blockIdx.x * 512 + tid; i < 2048 * 16; i += G * 512) wif[i] = w_in[(size_t)(i >> 4) * INW + O_IF + (i & 15)];
    }
}

__device__ __forceinline__ void p1_hnorm(const Args& a, LAS unsigned char* lds, int tid, int lane, int wave, int G) {
    unsigned char* ws = a.ws;
    const float* x = a.in[0]; const float* nw = a.in[2]; const float* w_in = a.in[5]; const float* b_in = a.in[6];
    const float* MOD = (const float*)(ws + WS_CTL) + CW_MOD;
    bf16_t* Hb = (bf16_t*)(ws + WS_H);
    float* misc = (float*)(ws + WS_MISC);
    LAS f32x4* wl = (LAS f32x4*)lds;
    LAS float* gl = (LAS float*)(lds + 131072);
    for (int it = blockIdx.x * NWAVES + wave; it < 32 * 64; it += G * NWAVES) {
        const int kb = it / 64, nb = it % 64;
        LAS float* scr = (LAS float*)(lds + wave * 16384);
        const float* src = a.in[11] + (size_t)(64 * kb) * DM + 32 * nb + 4 * (lane & 7);
        f32x4 v[8];
#pragma unroll
        for (int i = 0; i < 8; ++i) v[i] = *(const f32x4*)(src + (size_t)(8 * i + (lane >> 3)) * DM);
        float gt[4][4];
#pragma unroll
        for (int j = 0; j < 4; ++j)
#pragma unroll
            for (int bb = 0; bb < 4; ++bb) gt[j][bb] = MOD[bb * 6144 + 4096 + 32 * nb + (lane >> 3) + 8 * j];
#pragma unroll
        for (int i = 0; i < 8; ++i) { LAS float* d = scr + (8 * i + (lane >> 3)) * 33 + 4 * (lane & 7); d[0] = v[i][0]; d[1] = v[i][1]; d[2] = v[i][2]; d[3] = v[i][3]; }
        asm volatile("s_waitcnt lgkmcnt(0)" ::: "memory");
        const int c = lane & 7;
#pragma unroll
        for (int j = 0; j < 4; ++j) {
            const int n = (lane >> 3) + 8 * j; const LAS float* sp = scr + (8 * c) * 33 + n;
            float e[8];
#pragma unroll
            for (int q = 0; q < 8; ++q) e[q] = sp[q * 33];
#pragma unroll
            for (int bb = 0; bb < 4; ++bb) {
                const float gg = gt[j][bb];
                u32x4 o; o.x = pk_bf16(e[0] * gg, e[1] * gg); o.y = pk_bf16(e[2] * gg, e[3] * gg); o.z = pk_bf16(e[4] * gg, e[5] * gg); o.w = pk_bf16(e[6] * gg, e[7] * gg);
                *(u32x4*)((bf16_t*)(ws + WS_WOS) + (size_t)bb * DM * DM + pg8::ktm((size_t)(32 * nb + n), 64 * kb + 8 * c, 32)) = o;
            }
        }
        asm volatile("s_waitcnt lgkmcnt(0)" ::: "memory");
    }
    __syncthreads();
    {
        const f32x4* wif4 = (const f32x4*)(misc + MI_WIF);
#pragma unroll 1
        for (int hb = 0; hb < 2; ++hb) {
            f32x4 wq[8];
#pragma unroll
            for (int i = 0; i < 8; ++i) wq[i] = wif4[tid + 512 * (8 * hb + i)];
#pragma unroll
            for (int i = 0; i < 8; ++i) { const int q4 = tid + 512 * (8 * hb + i), k = q4 >> 2, gq = q4 & 3, e = k & 3, l = (k >> 2) & 63, jx = k >> 8; wl[((e * 8 + jx) * 4 + gq) * 64 + l] = wq[i]; }
        }
    }
    __syncthreads();
    const int gw = blockIdx.x * NWAVES + wave;
    const int rbase = gw * 8, b = rbase >> 12;
    f32x4 ms[8], sh[8];
#pragma unroll
    for (int j = 0; j < 8; ++j) {
        const int k = 4 * lane + 256 * j;
        const f32x4 nv = *(const f32x4*)(nw + k), scv = *(const f32x4*)(MOD + b * 6144 + 2048 + k);
        ms[j] = nv * (scv + 1.0f); sh[j] = *(const f32x4*)(MOD + b * 6144 + k);
    }
    for (int i = 0; i < 8; ++i) {
        const int row = rbase + i;
        const f32x4* xr = (const f32x4*)(x + (size_t)row * DM) + lane;
        f32x4 v[8]; float ss = 0.f;
#pragma unroll
        for (int j = 0; j < 8; ++j) { v[j] = xr[64 * j]; ss += (v[j][0] * v[j][0] + v[j][1] * v[j][1]) + (v[j][2] * v[j][2] + v[j][3] * v[j][3]); }
        const float rstd = rsqrtf(wave_sum(ss) * (1.f / DM) + EPS);
        f32x4 acc[4];
#pragma unroll
        for (int gq = 0; gq < 4; ++gq) acc[gq] = (f32x4){0.f, 0.f, 0.f, 0.f};
        u32x2* hrow = (u32x2*)(Hb + (size_t)row * DM) + lane;
#pragma unroll
        for (int j = 0; j < 8; ++j) {
            const f32x4 hv = v[j] * rstd * ms[j] + sh[j];
            u32x2 w; w.x = pk_bf16(hv[0], hv[1]); w.y = pk_bf16(hv[2], hv[3]);
            hrow[64 * j] = w;
#pragma unroll
            for (int e = 0; e < 4; ++e)
#pragma unroll
                for (int gq = 0; gq < 4; ++gq) acc[gq] += wl[((e * 8 + j) * 4 + gq) * 64 + lane] * hv[e];
            asm volatile("" ::: "memory");
        }
        float mine = 0.f;
#pragma unroll
        for (int gq = 0; gq < 4; ++gq)
#pragma unroll
            for (int e = 0; e < 4; ++e) { const float sgs = wave_sum(acc[gq][e]); mine = (lane == gq * 4 + e) ? sgs : mine; }
        if (lane < 16) {
            const float pre = mine + b_in[O_IF + lane];
            gl[lane * 64 + wave * 8 + i] = lane < 8 ? pre : (fminf(pre, 0.f) - log1pf(expf(-fabsf(pre))));
        }
    }
    __syncthreads();
    {
        const int hh = wave, jc = blockIdx.x & 63, bh = b * 8 + hh;
        const float li = gl[hh * 64 + lane], lf = gl[(8 + hh) * 64 + lane];
        float bc = lf;
#pragma unroll
        for (int o = 1; o < 64; o <<= 1) { const float t = __shfl_up(bc, o); if (lane >= o) bc += t; }
        const float av = li - bc;
        float cm = av;
#pragma unroll
        for (int o = 1; o < 64; o <<= 1) { const float t = __shfl_up(cm, o); if (lane >= o) cm = fmaxf(cm, t); }
        const size_t ti = (size_t)bh * SEQ + jc * 64 + lane;
        misc[MI_AA + ti] = av; misc[MI_CM + ti] = cm; misc[MI_BB + ti] = bc;
        if (lane == 63) { misc[MI_AMX + bh * 64 + jc] = cm; misc[MI_GS + bh * 64 + jc] = bc; }
    }
}

__device__ __forceinline__ f32x16 mfma32(bf16x8 a, bf16x8 b, f32x16 c) { return MFMA32(a, b, c); }

__device__ __forceinline__ void p3_scan(const Args& a, LAS unsigned char* lds, int tid, int lane, int wave, int vcu, int G) {
    unsigned char* ws = a.ws;
    {
        const float* SB = (const float*)(ws + WS_SB); const float* convw = a.in[7]; bf16_t* HB = (bf16_t*)(ws + WS_HAB);
        for (int idx = blockIdx.x * 512 + tid; idx < 256 * 512; idx += G * 512) {
            const int g = idx >> 9, ch = (idx & 511) * 4;
            const float* sb = SB + (size_t)g * 6 * 2048 + ch;
            f32x4 c62 = (f32x4){0.f, 0.f, 0.f, 0.f}, c63 = c62;
            if ((g & 63) != 0) { c62 = *(const f32x4*)(sb - 6 * 2048); c63 = *(const f32x4*)(sb - 5 * 2048); }
            const f32x4 bz0 = *(const f32x4*)(sb + 2 * 2048), bz1 = *(const f32x4*)(sb + 3 * 2048), p0 = *(const f32x4*)(sb + 4 * 2048), p1 = *(const f32x4*)(sb + 5 * 2048);
            const f32x4 w0 = *(const f32x4*)(convw + ch), w1 = *(const f32x4*)(convw + 2048 + ch);
            const f32x4 h0 = bz0 * (p0 + w0 * c62 + w1 * c63), h1 = bz1 * (p1 + w0 * c63);
            u32x2 o0, o1; o0.x = pk_bf16(h0[0], h0[1]); o0.y = pk_bf16(h0[2], h0[3]); o1.x = pk_bf16(h1[0], h1[1]); o1.y = pk_bf16(h1[2], h1[3]);
            *(u32x2*)(HB + pg8::ktm((size_t)(64 * g), 2048 + ch, 64)) = o0; *(u32x2*)(HB + pg8::ktm((size_t)(64 * g + 1), 2048 + ch, 64)) = o1;
        }
    }
    const int xcd = vcu >> 5, cu = vcu & 31, slot = wave * 32 + cu;
    if (G != 256 || slot >= 144) return;
    const int bh = xcd * 4 + slot / 36, rem = slot % 36, ib = rem / 9, jv = rem % 9;
    const int b = bh >> 3, hh = bh & 7, r = lane & 31, h = lane >> 5;
    const bf16_t* KT = (const bf16_t*)(ws + WS_KT); const bf16_t* VT = (const bf16_t*)(ws + WS_VT);
    bf16_t* CT = (bf16_t*)(ws + WS_CT);
    float* misc = (float*)(ws + WS_MISC);
    const float* AAp = misc + MI_AA + (size_t)bh * SEQ + lane;
    float* NJ = misc + MI_NJ + (size_t)bh * 64 * 128;
    const bf16_t* ktp = KT + ((size_t)bh * 64 * 16 + ib * 4) * 512 + lane * 8;
    const bf16_t* vtp = VT + ((size_t)bh * 64 * 32 + (jv & 7) * 4) * 512 + lane * 8;
    LAS float* wsl = (LAS float*)(lds + wave * 256);
    float msv, m63v;
    {
        const float amx = misc[MI_AMX + bh * 64 + lane], gs = misc[MI_GS + bh * 64 + lane];
        float Gc = gs, Cc = gs + amx;
#pragma unroll
        for (int o = 1; o < 64; o <<= 1) { const float Gp = __shfl_up(Gc, o), Cp = __shfl_up(Cc, o); if (lane >= o) { Cc = fmaxf(Cp + Gc, Cc); Gc = Gp + Gc; } }
        const float mnext = fmaxf(Gc, Cc);
        msv = __shfl_up(mnext, 1); if (lane == 0) msv = 0.f;
        m63v = fmaxf(msv, amx);
        if (rem == 8) misc[MI_MS + bh * 64 + lane] = msv;
    }
    f32x16 acc;
#pragma unroll
    for (int i = 0; i < 16; ++i) acc[i] = 0.f;
    const u32x4 ones = (u32x4){ONES16, ONES16, ONES16, ONES16};
    struct OpSet { bf16x8 A[4]; u32x4 B[4]; float a; };
    auto load_set = [&](OpSet& S, int jj) {
        const int jc = jj < NCH ? jj : NCH - 1;
        S.a = AAp[64 * jc];
#pragma unroll
        for (int ks = 0; ks < 4; ++ks) { S.A[ks] = *(const bf16x8*)(ktp + (size_t)jc * 16 * 512 + 512 * ks); S.B[ks] = *(const u32x4*)(vtp + (size_t)jc * 32 * 512 + 512 * ks); }
    };
    auto step = [&](int j, const OpSet& S) {
        const float ms_j = __int_as_float(__builtin_amdgcn_readlane(__float_as_int(msv), j)), m63 = __int_as_float(__builtin_amdgcn_readlane(__float_as_int(m63v), j));
        const float wgt = __expf(S.a - m63), keep = __expf(ms_j - m63);
        wsl[lane] = wgt;
        if (jv < 8) {
            bf16_t* cp = CT + ((((size_t)(bh * 64 + j) * 8 + jv) * 8 + 2 * ib) * 64 + r) * 8 + 4 * h;
#pragma unroll
            for (int q = 0; q < 4; ++q) { u32x2 w; w.x = pk_bf16(acc[4 * q], acc[4 * q + 1]); w.y = pk_bf16(acc[4 * q + 2], acc[4 * q + 3]); *(u32x2*)(cp + ((q >> 1) * 64 + (q & 1) * 32) * 8) = w; }
        } else if (r == 0) {
            float* np = NJ + (size_t)j * 128 + 32 * ib + 4 * h;
#pragma unroll
            for (int q = 0; q < 4; ++q) *(f32x4*)(np + 8 * q) = (f32x4){acc[4 * q], acc[4 * q + 1], acc[4 * q + 2], acc[4 * q + 3]};
        }
        acc = acc * keep;
#pragma unroll
        for (int ks = 0; ks < 4; ++ks) {
            const u32x4 raw = (jv < 8) ? S.B[ks] : ones;
            const f32x4 wa = *(const LAS f32x4*)(wsl + 16 * ks + 4 * h), wb = *(const LAS f32x4*)(wsl + 16 * ks + 8 + 4 * h);
            u32x4 o;
            o.x = pk_bf16(bf_lo(raw.x) * wa[0], bf_hi(raw.x) * wa[1]); o.y = pk_bf16(bf_lo(raw.y) * wa[2], bf_hi(raw.y) * wa[3]);
            o.z = pk_bf16(bf_lo(raw.z) * wb[0], bf_hi(raw.z) * wb[1]); o.w = pk_bf16(bf_lo(raw.w) * wb[2], bf_hi(raw.w) * wb[3]);
            acc = mfma32(S.A[ks], __builtin_bit_cast(bf16x8, o), acc);
        }
    };
    OpSet S0, S1, S2, S3;
    load_set(S0, 0); load_set(S1, 1); load_set(S2, 2);
    for (int j = 0; j < NCH; j += 4) {
        load_set(S3, j + 3); step(j, S0);
        load_set(S0, j + 4); step(j + 1, S1);
        load_set(S1, j + 5); step(j + 2, S2);
        load_set(S2, j + 6); step(j + 3, S3);
    }
}

template <int LB>
__device__ __forceinline__ void p4_unit(const bf16_t* Q, const bf16_t* Kr, const bf16_t* VT, const bf16_t* CT, const bf16_t* OG, const bf16_t* ZA, bf16_t* HA,
                                        const float* misc, const float* hnw, LAS float* ssq, int unit, int par, int dvg, int lane) {
    asm volatile("" : "+v"(lane));
    const int r = lane & 31, h = lane >> 5, l = 32 * LB + r;
    const int bh = unit >> 6, j = unit & 63, b = bh >> 3, hh = bh & 7, t0 = 64 * j;
    const size_t tok = (size_t)b * SEQ + t0 + l;
    const float cml = misc[MI_CM + (size_t)bh * SEQ + t0 + l], bbl = misc[MI_BB + (size_t)bh * SEQ + t0 + l], mst = misc[MI_MS + bh * 64 + j];
    const float* AAp = misc + MI_AA + (size_t)bh * SEQ + t0 + 4 * h;
    const float* njp = misc + MI_NJ + ((size_t)bh * 64 + j) * 128 + 8 * h;
    bf16x8 qf[8], kf[LB + 1][8], cf[2][8];
#pragma unroll
    for (int ks = 0; ks < 8; ++ks) qf[ks] = *(const bf16x8*)(Q + ((size_t)(unit * 2 + LB) * 8 + ks) * 512 + lane * 8);
#pragma unroll
    for (int ks = 0; ks < 8; ++ks) { cf[0][ks] = *(const bf16x8*)(CT + (((size_t)unit * 8 + 2 * dvg) * 8 + ks) * 512 + lane * 8); cf[1][ks] = *(const bf16x8*)(CT + (((size_t)unit * 8 + 2 * dvg + 1) * 8 + ks) * 512 + lane * 8); }
#pragma unroll
    for (int sb = 0; sb <= LB; ++sb) {
#pragma unroll
        for (int ks = 0; ks < 8; ++ks) kf[sb][ks] = *(const bf16x8*)(Kr + ((size_t)(unit * 2 + sb) * 8 + ks) * 512 + lane * 8);
    }
    asm volatile("" ::: "memory");
    const float Ml = fmaxf(mst, cml), el = -bbl - Ml, winter = __expf(mst - Ml);
    f32x16 o0, o1;
#pragma unroll
    for (int i = 0; i < 16; ++i) { o0[i] = 0.f; o1[i] = 0.f; }
    float deni = 0.f;
#pragma unroll
    for (int ks = 0; ks < 8; ++ks) {
        const u32x4 qr = __builtin_bit_cast(u32x4, qf[ks]);
        const f32x4 n0 = *(const f32x4*)(njp + 16 * ks), n1 = *(const f32x4*)(njp + 16 * ks + 4);
        deni += (bf_lo(qr.x) * n0[0] + bf_hi(qr.x) * n0[1]) + (bf_lo(qr.y) * n0[2] + bf_hi(qr.y) * n0[3]) + (bf_lo(qr.z) * n1[0] + bf_hi(qr.z) * n1[1]) + (bf_lo(qr.w) * n1[2] + bf_hi(qr.w) * n1[3]);
        o0 = mfma32(cf[0][ks], qf[ks], o0);
        o1 = mfma32(cf[1][ks], qf[ks], o1);
    }
    u32x4 va[LB + 1][2][2];
#pragma unroll
    for (int sb = 0; sb <= LB; ++sb)
#pragma unroll
        for (int sp = 0; sp < 2; ++sp)
#pragma unroll
            for (int db = 0; db < 2; ++db) va[sb][sp][db] = *(const u32x4*)(VT + (((size_t)unit * 8 + 2 * dvg + db) * 4 + 2 * sb + sp) * 512 + lane * 8);
    f32x4 a4[LB + 1][4];
#pragma unroll
    for (int sb = 0; sb <= LB; ++sb)
#pragma unroll
        for (int q = 0; q < 4; ++q) a4[sb][q] = *(const f32x4*)(AAp + 32 * sb + 8 * q);
    asm volatile("" ::: "memory");
    o0 = o0 * winter; o1 = o1 * winter; deni *= winter;
    f32x16 s[LB + 1];
#pragma unroll
    for (int sb = 0; sb <= LB; ++sb) {
#pragma unroll
        for (int i = 0; i < 16; ++i) s[sb][i] = 0.f;
#pragma unroll
        for (int ks = 0; ks < 8; ++ks) s[sb] = mfma32(kf[sb][ks], qf[ks], s[sb]);
    }
    const size_t gzo = (((size_t)(unit * 2 + LB) * 32 + 8 * dvg) * 64 + lane) * 4;
    u32x2 og[2][4], za[2][4];
#pragma unroll
    for (int db = 0; db < 2; ++db)
#pragma unroll
        for (int q = 0; q < 4; ++q) { og[db][q] = *(const u32x2*)(OG + gzo + (4 * db + q) * 256); za[db][q] = *(const u32x2*)(ZA + gzo + (4 * db + q) * 256); }
    asm volatile("" ::: "memory");
    float den = 0.f;
#pragma unroll
    for (int sb = 0; sb <= LB; ++sb) {
        float pv[16];
#pragma unroll
        for (int q = 0; q < 4; ++q)
#pragma unroll
            for (int e = 0; e < 4; ++e) {
                const int srow = 32 * sb + 8 * q + 4 * h + e;
                const float d = (sb < LB || srow <= l) ? __expf(a4[sb][q][e] - Ml) : 0.f;
                const float p = s[sb][4 * q + e] * d; pv[4 * q + e] = p; den += p;
            }
#pragma unroll
        for (int sp = 0; sp < 2; ++sp) {
            u32x4 pb; pb.x = pk_bf16(pv[8 * sp], pv[8 * sp + 1]); pb.y = pk_bf16(pv[8 * sp + 2], pv[8 * sp + 3]); pb.z = pk_bf16(pv[8 * sp + 4], pv[8 * sp + 5]); pb.w = pk_bf16(pv[8 * sp + 6], pv[8 * sp + 7]);
            const bf16x8 bfr = __builtin_bit_cast(bf16x8, pb);
            o0 = mfma32(__builtin_bit_cast(bf16x8, va[sb][sp][0]), bfr, o0);
            o1 = mfma32(__builtin_bit_cast(bf16x8, va[sb][sp][1]), bfr, o1);
        }
    }
    float dtot = den + deni; dtot += __shfl_xor(dtot, 32);
    const float inv = 1.f / fmaxf(fabsf(dtot), __expf(el));
    float hg[32]; float ss = 0.f;
#pragma unroll
    for (int q = 0; q < 4; ++q) {
        hg[4 * q + 0] = o0[4 * q + 0] * inv * bf_lo(og[0][q].x); hg[4 * q + 1] = o0[4 * q + 1] * inv * bf_hi(og[0][q].x); hg[4 * q + 2] = o0[4 * q + 2] * inv * bf_lo(og[0][q].y); hg[4 * q + 3] = o0[4 * q + 3] * inv * bf_hi(og[0][q].y);
        hg[16 + 4 * q + 0] = o1[4 * q + 0] * inv * bf_lo(og[1][q].x); hg[16 + 4 * q + 1] = o1[4 * q + 1] * inv * bf_hi(og[1][q].x); hg[16 + 4 * q + 2] = o1[4 * q + 2] * inv * bf_lo(og[1][q].y); hg[16 + 4 * q + 3] = o1[4 * q + 3] * inv * bf_hi(og[1][q].y);
    }
#pragma unroll
    for (int i = 0; i < 32; ++i) ss += hg[i] * hg[i];
    ss += __shfl_xor(ss, 32);
    if (h == 0) ssq[(par * 4 + dvg) * 64 + l] = ss;
    const float* hwp = hnw + hh * 256 + 64 * dvg + 4 * h;
    f32x4 hwv[2][4];
#pragma unroll
    for (int db = 0; db < 2; ++db)
#pragma unroll
        for (int q = 0; q < 4; ++q) hwv[db][q] = *(const f32x4*)(hwp + 32 * db + 8 * q);
    __syncthreads();
    const float tot = (ssq[(par * 4 + 0) * 64 + l] + ssq[(par * 4 + 1) * 64 + l]) + (ssq[(par * 4 + 2) * 64 + l] + ssq[(par * 4 + 3) * 64 + l]);
    const float rstd = rsqrtf(tot * (1.f / DV) + EPS);
    LAS unsigned char* patch = (LAS unsigned char*)ssq + 4096 + (dvg * 2 + LB) * 4608;
#pragma unroll
    for (int q = 0; q < 4; ++q) {
#pragma unroll
        for (int db = 0; db < 2; ++db) {
            const u32x2 z = za[db][q]; const f32x4 hw = hwv[db][q];
            const float v0 = hg[16 * db + 4 * q + 0] * rstd * hw[0] * bf_lo(z.x), v1 = hg[16 * db + 4 * q + 1] * rstd * hw[1] * bf_hi(z.x);
            const float v2 = hg[16 * db + 4 * q + 2] * rstd * hw[2] * bf_lo(z.y), v3 = hg[16 * db + 4 * q + 3] * rstd * hw[3] * bf_hi(z.y);
            u32x2 w; w.x = pk_bf16(v0, v1); w.y = pk_bf16(v2, v3);
            *(LAS u32x2*)(patch + r * 144 + (32 * db + 8 * q + 4 * h) * 2) = w;
        }
    }
    asm volatile("s_waitcnt lgkmcnt(0)" ::: "memory");
    bf16_t* hap = HA + pg8::ktm((size_t)b * SEQ + t0 + 32 * LB, hh * 256 + 64 * dvg, 64) + lane * 8;
#pragma unroll
    for (int i = 0; i < 4; ++i) {
        const u32x4 w = *(const LAS u32x4*)(patch + (8 * i + (lane >> 3)) * 144 + (lane & 7) * 16);
        *(u32x4*)(hap + i * 512) = w;
    }
}

__device__ __forceinline__ void p4_mlstm_out(const Args& a, LAS unsigned char* lds, int tid, int lane, int wave, int vcu, int G) {
    unsigned char* ws = a.ws;
    const bf16_t* Q = (const bf16_t*)(ws + WS_Q); const bf16_t* Kr = (const bf16_t*)(ws + WS_K); const bf16_t* VT = (const bf16_t*)(ws + WS_VT);
    const bf16_t* CT = (const bf16_t*)(ws + WS_CT); const bf16_t* OG = (const bf16_t*)(ws + WS_OG); const bf16_t* ZA = (const bf16_t*)(ws + WS_ZA);
    bf16_t* HA = (bf16_t*)(ws + WS_HAB);
    const float* misc = (const float*)(ws + WS_MISC); const float* hnw = a.in[8];
    LAS float* ssq = (LAS float*)lds;
    const int lb = wave & 1, dvg = wave >> 1;
    int par = 0;
    for (int unit = vcu; unit < 32 * NCH; unit += G, par ^= 1) {
        if (lb == 0) p4_unit<0>(Q, Kr, VT, CT, OG, ZA, HA, misc, hnw, ssq, unit, par, dvg, lane);
        else p4_unit<1>(Q, Kr, VT, CT, OG, ZA, HA, misc, hnw, ssq, unit, par, dvg, lane);
    }
}

constexpr int N_PHASES = 7;
__global__ void __launch_bounds__(NWAVES * 64, 2) fwd_kernel(Args args) {
    extern __shared__ __attribute__((aligned(16))) unsigned char lds_raw[];
    LAS unsigned char* lds = (LAS unsigned char*)lds_raw;
    const int tid = threadIdx.x, lane = tid & 63, wave = __builtin_amdgcn_readfirstlane(tid >> 6);
    const int G = gridDim.x; const int bx = blockIdx.x; const int vcu = (G % 8 == 0) ? (bx % 8) * (G / 8) + bx / 8 : bx;
    unsigned char* ws = args.ws;
    volatile LAS unsigned* bst = (volatile LAS unsigned*)(lds + LDS_BYTES - 64);
    if (tid < 16) bst[tid] = 0u;
    __syncthreads();
    XcdBarrier bar; bar.bar = (unsigned*)(ws + WS_CTL) + CW_BAR + args.li * XCD_BAR_WORDS; bar.x = 0; bar.st = nullptr;
    const int lo = args.ph_lo, hi = args.ph_hi;
    if (hi - lo > 1) bar = xcd_barrier_post((unsigned*)(ws + WS_CTL) + CW_BAR + args.li * XCD_BAR_WORDS, bst);
#ifndef PH_MASK
#define PH_MASK 0x7f
#endif
#define IN(k) (((PH_MASK >> (k)) & 1) && lo <= (k) && (k) < hi)
#define SEAM(k) do { if (IN(k) && IN((k) + 1)) xcd_barrier(bar); } while (0)
    if (IN(0)) { p0_prep(args, lds, tid, lane, wave, vcu, G); } SEAM(0);
    if (IN(1)) { p1_hnorm(args, lds, tid, lane, wave, G); } SEAM(1);
    if (IN(2)) {
        pg8::Gemm g{(const bf16_t*)(ws + WS_H), (const bf16_t*)(ws + WS_WINT), MTOK, NPRJ, DM, DM, 64, 0, 0, 128, 256 * DM * 2, 0, 32768, 32 * 32768};
        pg8::StaticOrder S; S.init(MTOK, NPRJ, G, bx);
        pg8::EpiInProj E{(bf16_t*)(ws + WS_Q), (bf16_t*)(ws + WS_K), (bf16_t*)(ws + WS_KT), (bf16_t*)(ws + WS_VT), (bf16_t*)(ws + WS_OG), (bf16_t*)(ws + WS_ZA),
                         (bf16_t*)(ws + WS_HAB), (bf16_t*)args.out, (bf16_t*)args.out + (size_t)MTOK * DM,
                         (const float*)(ws + WS_MISC) + MI_BPERM, args.in[7], (float*)(ws + WS_SB), 4096, lds + 131072};
        pg8::gemm_phase<pg8::EpiInProj, true, true>(lds, g, S, E);
    } SEAM(2);
    if (IN(3)) { p3_scan(args, lds, tid, lane, wave, vcu, G); } SEAM(3);
    if (IN(4)) { p4_mlstm_out(args, lds, tid, lane, wave, vcu, G); } SEAM(4);
    if (IN(5)) {
        pg8::Gemm g{(const bf16_t*)(ws + WS_HAB), (const bf16_t*)(ws + WS_WAB), MTOK, DM, DM, 64, 64, 32 * 32768, 0, 32768, 64 * 32768, 32 * 32768, 32768, 64 * 32768};
        pg8::MergeOrder S; S.so.init(MTOK, DM, G, bx);
        pg8::EpiMerge E{(const bf16_t*)args.out, (const bf16_t*)args.out + (size_t)MTOK * DM, (bf16_t*)(ws + WS_MG)};
        pg8::gemm_phase<pg8::EpiMerge, true, true, pg8::MergeOrder>(lds, g, S, E);
    } SEAM(5);
    if (IN(6)) {
        pg8::Gemm g{(const bf16_t*)(ws + WS_MG), (const bf16_t*)(ws + WS_WOS), MTOK, DM, DM, 64, 64, 0, DM * DM * 2, 32768, 32 * 32768, 0, 32768, 32 * 32768};
        pg8::PanelOrder S{vcu};
        pg8::EpiOutNorm E{args.in[0], (const float*)(ws + WS_CTL) + CW_MOD + 4096, args.in[12], args.out, (float*)(ws + WS_CTL) + CW_ROWSS, (unsigned*)(ws + WS_CTL) + CW_CNT};
        pg8::gemm_phase<pg8::EpiOutNorm, true, true, pg8::PanelOrder>(lds, g, S, E);
    }
#undef IN
#undef SEAM
}

extern "C" void kernel_launch(void* const* d_in, const int* in_sizes, int n_in, void* d_out, int out_size, void* d_ws, size_t ws_size, hipStream_t stream) {
    static int grid = 0;
    if (grid == 0) {
        if (n_in != 13 || out_size != MTOK * DM || ws_size < WS_END) { fprintf(stderr, "kernel_launch: unexpected problem (n_in %d, out %d, ws %zu)\n", n_in, out_size, ws_size); grid = -1; return; }
        int dev = 0, cus = 0, per_cu = 0;
        if (hipGetDevice(&dev) != hipSuccess || hipDeviceGetAttribute(&cus, hipDeviceAttributeMultiprocessorCount, dev) != hipSuccess) { grid = -1; return; }
        if (hipFuncSetAttribute((const void*)fwd_kernel, hipFuncAttributeMaxDynamicSharedMemorySize, LDS_BYTES) != hipSuccess) { fprintf(stderr, "kernel_launch: hipFuncSetAttribute failed\n"); grid = -1; return; }
        if (hipOccupancyMaxActiveBlocksPerMultiprocessor(&per_cu, (const void*)fwd_kernel, NWAVES * 64, LDS_BYTES) != hipSuccess || per_cu < 1) { fprintf(stderr, "kernel_launch: occupancy query says %d blocks per CU\n", per_cu); }
        (void)hipGetLastError();
        grid = cus;
        if (grid != 256) fprintf(stderr, "kernel_launch: %d CUs; the phase program is laid out for 256\n", grid);
    }
    if (grid < 0) return;
    (void)hipMemsetAsync((char*)d_ws + WS_CTL, 0, CTL_ZERO_BYTES, stream);
    Args a{};
    for (int i = 0; i < 13; ++i) a.in[i] = (const float*)d_in[i];
    a.out = (float*)d_out; a.ws = (unsigned char*)d_ws;
#ifdef PROF_SEQ
    if (true) {
        const int seq[][2] = PROF_SEQ;
        for (unsigned i = 0; i < sizeof(seq) / sizeof(seq[0]); ++i) { a.ph_lo = seq[i][0]; a.ph_hi = seq[i][1]; a.li = i; hipLaunchKernelGGL(fwd_kernel, dim3(grid), dim3(NWAVES * 64), LDS_BYTES, stream, a); }
    } else
#endif
    if (MK_N_LAUNCHES == 1) {
        a.ph_lo = 0; a.ph_hi = N_PHASES; a.li = 0;
        hipLaunchKernelGGL(fwd_kernel, dim3(grid), dim3(NWAVES * 64), LDS_BYTES, stream, a);
    } else {
        for (int p = 0; p < N_PHASES; ++p) { a.ph_lo = p; a.ph_hi = p + 1; a.li = p; hipLaunchKernelGGL(fwd_kernel, dim3(grid), dim3(NWAVES * 64), LDS_BYTES, stream, a); }
    }
}
```

```cpp
#include <hip/hip_runtime.h>
#include <cstdio>
#include <cstdint>
#include <type_traits>

#ifndef MK_N_LAUNCHES
#define MK_N_LAUNCHES 1
#endif

#define LAS __attribute__((address_space(3)))
typedef unsigned short bf16_t;
typedef short bf16x8 __attribute__((ext_vector_type(8)));
typedef short s16x4 __attribute__((ext_vector_type(4)));
typedef float f32x2 __attribute__((ext_vector_type(2)));
typedef float f32x4 __attribute__((ext_vector_type(4)));
typedef float f32x16 __attribute__((ext_vector_type(16)));
typedef unsigned u32x2 __attribute__((ext_vector_type(2)));
typedef unsigned u32x4 __attribute__((ext_vector_type(4)));
#ifndef USE_FP16
#define USE_FP16 0
#endif
#if USE_FP16
typedef _Float16 h2_t __attribute__((ext_vector_type(2)));
typedef _Float16 h8_t __attribute__((ext_vector_type(8)));
#define ONES16 0x3c003c00u
#define MFMA16(a, b, c) __builtin_amdgcn_mfma_f32_16x16x32_f16(__builtin_bit_cast(h8_t, a), __builtin_bit_cast(h8_t, b), c, 0, 0, 0)
#define MFMA32(a, b, c) __builtin_amdgcn_mfma_f32_32x32x16_f16(__builtin_bit_cast(h8_t, a), __builtin_bit_cast(h8_t, b), c, 0, 0, 0)
#else
typedef __bf16 h2_t __attribute__((ext_vector_type(2)));
#define ONES16 0x3f803f80u
#define MFMA16(a, b, c) __builtin_amdgcn_mfma_f32_16x16x32_bf16(a, b, c, 0, 0, 0)
#define MFMA32(a, b, c) __builtin_amdgcn_mfma_f32_32x32x16_bf16(a, b, c, 0, 0, 0)
#endif

constexpr int NB = 4, SEQ = 4096, DM = 2048, MTOK = NB * SEQ;
constexpr int NH = 8, DK = 128, DV = 256, CH = 64, NCH = SEQ / CH;
constexpr int INW = 20496, NPRJ = 20480;
constexpr int O_IF = 8192;
constexpr float EPS = 1e-6f;

__device__ __forceinline__ unsigned pk_bf16(float lo, float hi) { f32x2 v = {lo, hi}; h2_t b = __builtin_convertvector(v, h2_t); return __builtin_bit_cast(unsigned, b); }
#if USE_FP16
__device__ __forceinline__ float bf_lo(unsigned u) { return (float)__builtin_bit_cast(h2_t, u)[0]; }
__device__ __forceinline__ float bf_hi(unsigned u) { return (float)__builtin_bit_cast(h2_t, u)[1]; }
#else
__device__ __forceinline__ float bf_lo(unsigned u) { return __uint_as_float(u << 16); }
__device__ __forceinline__ float bf_hi(unsigned u) { return __uint_as_float(u & 0xffff0000u); }
#endif
__device__ __forceinline__ float sigmoid_f(float x) { return __builtin_amdgcn_rcpf(1.f + __builtin_amdgcn_exp2f(x * -1.4426950408889634f)); }
__device__ __forceinline__ float silu_f(float x) { return x * sigmoid_f(x); }
__device__ __forceinline__ float silu_acc(float x) { return x / (1.f + expf(-x)); }
__device__ __forceinline__ float wave_sum(float v) {
#pragma unroll
    for (int o = 1; o < 64; o <<= 1) v += __shfl_xor(v, o);
    return v;
}

__device__ __forceinline__ int win_src_col(int np) {
    const int pn = np >> 8, jc = np & 255;
    if (pn < 32) return np;
    if (pn < 64) {
        const int c = pn - 32, bj = jc >> 7, wc = (jc >> 5) & 3, fq = (jc >> 3) & 3, n = (jc >> 2) & 1, e = jc & 3;
        return 8208 + 2048 * (2 * bj + n) + 64 * c + 16 * wc + 4 * fq + e;
    }
    return ((jc >> 7) ? 18448 : 16400) + 128 * (pn - 64) + (jc & 127);
}

namespace pg8 {
constexpr int BM = 256, BK = 64, HALF = 128, HTB = HALF * BK * 2, STAGE_BYTES = 8 * HTB, NXCD = 8, WGM = 8;
__host__ __device__ __forceinline__ int lds_byte(int r, int c) { const int st = (r >> 4) * 2 + (c >> 5), rr = r & 15, cc = c & 31, ob = rr * 64 + cc * 2; return st * 1024 + (ob ^ (((ob >> 9) & 1) << 5)); }
__host__ __device__ __forceinline__ void stage_rc(int b, int& R, int& C) { const int st = b / 1024, sb = b % 1024, swz = sb ^ (((sb >> 9) & 1) << 5); R = (st >> 1) * 16 + swz / 64; C = (st & 1) * 32 + (swz % 64) / 2; }
__host__ __device__ __forceinline__ int perm32(int rho) { const int n = rho >> 4, i = rho & 15; return 8 * (i >> 2) + 4 * n + (i & 3); }

__device__ __forceinline__ float ror8(float x) { return __int_as_float(__builtin_amdgcn_update_dpp(0, __float_as_int(x), 0x128, 0xf, 0xf, false)); }
__device__ __forceinline__ f32x4 ror8(f32x4 v) { return (f32x4){ror8(v[0]), ror8(v[1]), ror8(v[2]), ror8(v[3])}; }
__host__ __device__ __forceinline__ size_t ktm(size_t row, int col, int nkt) { return (row >> 8) * ((size_t)nkt * 16384) + (size_t)(col >> 6) * 16384 + (row & 255) * 64 + (size_t)(col & 63); }
struct Unit { int pm, pn, which, par; };
struct Gemm { const bf16_t* A; const bf16_t* Bt; int M, N, K, lda, ldb, koff, bb, ksA, tsA, koffA, ksB, tsB; };

struct StaticOrder {
    int nM, nN, nwg, G, c;
    __device__ void init(int M, int N, int G_, int c_) { nM = M / BM; nN = N / BM; nwg = nM * nN; G = G_; c = c_; }
    __device__ bool next(int i, Unit& u) const {
        const long L = (long)i * G + c; if (L >= nwg) return false;
        int wgid = (int)L; { const int q = nwg / NXCD, r = nwg % NXCD, xcd = wgid % NXCD, off = wgid / NXCD; wgid = (xcd < r ? xcd * (q + 1) : r * (q + 1) + (xcd - r) * q) + off; }
        const int nig = WGM * nN, gid = wgid / nig, fm = gid * WGM, gsz = (nM - fm) < WGM ? (nM - fm) : WGM;
        u.pm = fm + ((wgid % nig) % gsz); u.pn = (wgid % nig) / gsz; u.which = 0; return true;
    }
};

template <class Epi, bool ALIGN_EPI, bool SP2, class Sched = StaticOrder>
__device__ __forceinline__ void gemm_phase(LAS unsigned char* lds, const Gemm g, const Sched& S, const Epi& E) {
    int tid = threadIdx.x; asm volatile("" : "+v"(tid));
    const int wid = __builtin_amdgcn_readfirstlane(tid >> 6), lane = tid & 63, wr = wid >> 2, wc = wid & 3, fr = lane & 15, fq = lane >> 4;
    const int K = g.K, nt = K / BK;
    unsigned voffA[2], voffB[2];
#pragma unroll
    for (int i = 0; i < 2; ++i) { int R, C; stage_rc(tid * 16 + i * 8192, R, C); const int Rb = Epi::PERM ? ((R & ~31) + perm32(R & 31)) : R;
        voffA[i] = (unsigned)(R * g.lda + C) * 2u; voffB[i] = (unsigned)(Rb * g.ldb + C) * 2u; }
    const size_t kstep = (size_t)g.ksB;
    const size_t hstepA = (size_t)HALF * g.lda * 2, hstepB = (size_t)HALF * g.ldb * 2;
    const size_t tstepA = (size_t)g.tsA, tstepB = (size_t)g.tsB, kstepA = (size_t)g.ksA;
    const unsigned ldsw = (unsigned)wid * 1024u;
    const int aoff = lds_byte(wr * 64 + fr, fq * 8), boff = lds_byte(wc * 32 + fr, fq * 8);
#define PG8_SA(b, h) (((b) * 2 + (h)) * HTB)
#define PG8_SB(b, h) ((4 + (b) * 2 + (h)) * HTB)
#define PG8_STAGE(bufoff, gbase, voff) do { const char* _gb = (const char*)(gbase); if constexpr (Epi::KHOOK) asm volatile("" : "+s"(_gb)); _Pragma("unroll") for (int _i = 0; _i < 2; ++_i) \
        __builtin_amdgcn_global_load_lds((const unsigned*)(_gb + (voff)[_i]), (LAS unsigned*)(lds + (bufoff) + ldsw + _i * 8192), 16, 0, 0); } while (0)
#define PG8_LDA(dst, b, h) do { _Pragma("unroll") for (int m = 0; m < 4; ++m) _Pragma("unroll") for (int k = 0; k < 2; ++k) dst[m][k] = *(const LAS bf16x8*)(lds + PG8_SA(b, h) + aoff + m * 2048 + k * 1024); } while (0)
#define PG8_LDB(dst, b, h) do { _Pragma("unroll") for (int n = 0; n < 2; ++n) _Pragma("unroll") for (int k = 0; k < 2; ++k) dst[n][k] = *(const LAS bf16x8*)(lds + PG8_SB(b, h) + boff + n * 2048 + k * 1024); } while (0)
#define PG8_MMA(ai, bj, At, Bt) do { __builtin_amdgcn_s_setprio(1); _Pragma("unroll") for (int m = 0; m < 4; ++m) _Pragma("unroll") for (int n = 0; n < 2; ++n) _Pragma("unroll") for (int k = 0; k < 2; ++k) \
        acc[ai][bj][m][n] = MFMA16(Bt[n][k], At[m][k], acc[ai][bj][m][n]); __builtin_amdgcn_s_setprio(0); } while (0)
#define PG8_WAIT_V(n) asm volatile("s_waitcnt vmcnt(" #n ")" ::: "memory")
#define PG8_WAIT_L(n) asm volatile("s_waitcnt lgkmcnt(" #n ")" ::: "memory")
#define PG8_BAR __builtin_amdgcn_s_barrier()
#define PG8_SCHED __builtin_amdgcn_sched_barrier(0)
    Unit cur, nxt; int ui = 0;
    if (!S.next(0, cur)) return;
    cur.par = 0;
    f32x4 acc[2][2][4][2];
#pragma unroll
    for (int a = 0; a < 2; ++a)
#pragma unroll
        for (int b = 0; b < 2; ++b)
#pragma unroll
            for (int m = 0; m < 4; ++m)
#pragma unroll
                for (int n = 0; n < 2; ++n) acc[a][b][m][n] = (f32x4){0.f, 0.f, 0.f, 0.f};
    bf16x8 At[4][2], B0[2][2], B1[2][2];
    const char* cA = (const char*)g.A + (size_t)cur.pm * tstepA + (size_t)cur.which * g.koffA; const char* cB = (const char*)g.Bt + (size_t)cur.pn * tstepB + (size_t)cur.which * g.koff + (size_t)(cur.pm >> 4) * g.bb;
    const float* hkb = nullptr; unsigned hkoffA = 0, hkoffB = 0; f32x4 hx0, hx1;
    if constexpr (Epi::KHOOK) {
        hkb = E.hook_base(cur);
        hkoffA = (unsigned)(((wr * 64 + (fr & 7)) * g.N + wc * 32 + 4 * fq + (fr < 8 ? 0 : 16)) * 4); hkoffB = (unsigned)(((wr * 64 + 8 + (fr & 7)) * g.N + wc * 32 + 4 * fq + (fr < 8 ? 16 : 0)) * 4);
    }
    if constexpr (Epi::LDS_CONST) { if (wid == 0) E.stage_consts(cur, lds, lane); }
    if constexpr (SP2) {
        PG8_STAGE(PG8_SB(0, 0), cB, voffB); PG8_STAGE(PG8_SB(0, 1), cB + hstepB, voffB); PG8_STAGE(PG8_SA(0, 0), cA, voffA); PG8_STAGE(PG8_SA(0, 1), cA + hstepA, voffA);
        if (wr == 1) PG8_BAR;
        PG8_WAIT_V(2); PG8_BAR;
        PG8_STAGE(PG8_SB(1, 0), cB + kstep, voffB); PG8_STAGE(PG8_SA(1, 0), cA + kstepA, voffA); PG8_STAGE(PG8_SB(1, 1), cB + hstepB + kstep, voffB);
        PG8_WAIT_V(6); PG8_BAR;
    } else {
        PG8_STAGE(PG8_SB(0, 0), cB, voffB); PG8_STAGE(PG8_SA(0, 0), cA, voffA); PG8_STAGE(PG8_SB(0, 1), cB + hstepB, voffB); PG8_STAGE(PG8_SA(0, 1), cA + hstepA, voffA);
        if (wr == 1) PG8_BAR;
        PG8_WAIT_V(4); PG8_BAR;
        PG8_STAGE(PG8_SB(1, 0), cB + kstep, voffB); PG8_STAGE(PG8_SA(1, 0), cA + kstepA, voffA); PG8_STAGE(PG8_SB(1, 1), cB + hstepB + kstep, voffB);
        PG8_WAIT_V(6); PG8_BAR;
    }
    for (;;) {
        const bool has_next = S.next(ui + 1, nxt); nxt.par = (ui + 1) & 1;
        const char* nA = has_next ? (const char*)g.A + (size_t)nxt.pm * tstepA + (size_t)nxt.which * g.koffA : cA; const char* nB = has_next ? (const char*)g.Bt + (size_t)nxt.pn * tstepB + (size_t)nxt.which * g.koff + (size_t)(nxt.pm >> 4) * g.bb : cB;
        for (int t0 = 0; t0 < nt; t0 += (Epi::KHOOK ? 8 : 2)) {
#pragma unroll
          for (int hu = 0; hu < (Epi::KHOOK ? 4 : 1); ++hu) {
            const int t = t0 + 2 * hu;
            const bool last = (t == nt - 2);
            const char* a1 = cA + (size_t)(t + 1) * kstepA;
            const char* a2 = last ? nA : cA + (size_t)(t + 2) * kstepA; const char* b2 = last ? nB : cB + (size_t)(t + 2) * kstep;
            const char* a3 = a2 + kstepA; const char* b3 = b2 + kstep;
            if constexpr (SP2) {
            PG8_LDB(B0, 0, 0); PG8_LDB(B1, 0, 1); PG8_SCHED; PG8_LDA(At, 0, 0); PG8_STAGE(PG8_SA(1, 1), a1 + hstepA, voffA);
            if constexpr (Epi::KHOOK) {
                const int hq = t0 >> 3; const float* hp = hkb + (size_t)((hq >> 1) * HALF + hu * 16) * g.N + (hq & 1) * HALF;
                asm volatile("global_load_dwordx4 %0, %1, %2" : "=&v"(hx0) : "v"(hkoffA), "s"(hp) : "memory");
                asm volatile("global_load_dwordx4 %0, %1, %2" : "=&v"(hx1) : "v"(hkoffB), "s"(hp) : "memory");
                PG8_WAIT_V(10);
            } else { PG8_WAIT_V(8); }
            PG8_WAIT_L(0); PG8_BAR; PG8_MMA(0, 0, At, B0); PG8_MMA(0, 1, At, B1); PG8_BAR; PG8_SCHED;
            PG8_LDA(At, 0, 1); PG8_STAGE(PG8_SB(0, 0), b2, voffB); PG8_STAGE(PG8_SB(0, 1), b2 + hstepB, voffB); PG8_STAGE(PG8_SA(0, 0), a2, voffA);
            if constexpr (Epi::KHOOK) { PG8_WAIT_V(10); } else { PG8_WAIT_V(8); }
            PG8_WAIT_L(0); PG8_BAR; PG8_MMA(1, 0, At, B0); PG8_MMA(1, 1, At, B1); PG8_BAR; PG8_SCHED;
            PG8_LDB(B0, 1, 0); PG8_LDB(B1, 1, 1); PG8_SCHED; PG8_LDA(At, 1, 0); PG8_STAGE(PG8_SA(0, 1), a2 + hstepA, voffA);
            PG8_WAIT_V(8); PG8_WAIT_L(0); PG8_BAR; PG8_MMA(0, 0, At, B0); PG8_MMA(0, 1, At, B1); PG8_BAR; PG8_SCHED;
            if constexpr (Epi::KHOOK) {
                const int hq = t0 >> 3;
                const bool lo8 = fr < 8;
                f32x4 own0, oth;
#pragma unroll
                for (int e = 0; e < 4; ++e) { own0[e] = lo8 ? hx0[e] : hx1[e]; oth[e] = lo8 ? hx1[e] : hx0[e]; }
                const f32x4 own1 = ror8(oth);
#pragma unroll
                for (int q = 0; q < 4; ++q) { const float sel = (hq == q) ? 1.f : 0.f;
                    acc[q >> 1][q & 1][hu][0] += own0 * sel; acc[q >> 1][q & 1][hu][1] += own1 * sel; }
                PG8_SCHED;
            }
            PG8_LDA(At, 1, 1); PG8_STAGE(PG8_SB(1, 0), b3, voffB); PG8_STAGE(PG8_SB(1, 1), b3 + hstepB, voffB); PG8_STAGE(PG8_SA(1, 0), a3, voffA);
            PG8_WAIT_V(8); PG8_WAIT_L(0); PG8_BAR; PG8_MMA(1, 0, At, B0); PG8_MMA(1, 1, At, B1); PG8_BAR; PG8_SCHED;
            } else {
            PG8_LDB(B0, 0, 0); PG8_SCHED; PG8_LDA(At, 0, 0); PG8_STAGE(PG8_SA(1, 1), a1 + hstepA, voffA);
            PG8_WAIT_L(8); PG8_BAR; PG8_WAIT_L(0); PG8_MMA(0, 0, At, B0); PG8_BAR; PG8_SCHED;
            PG8_LDB(B1, 0, 1); PG8_STAGE(PG8_SB(0, 0), b2, voffB);
            PG8_BAR; PG8_WAIT_L(0); PG8_MMA(0, 1, At, B1); PG8_BAR;
            PG8_LDA(At, 0, 1); PG8_STAGE(PG8_SA(0, 0), a2, voffA);
            PG8_BAR; PG8_WAIT_L(0); PG8_MMA(1, 0, At, B0); PG8_BAR; PG8_SCHED;
            PG8_STAGE(PG8_SB(0, 1), b2 + hstepB, voffB);
            PG8_WAIT_V(6); PG8_BAR; PG8_MMA(1, 1, At, B1); PG8_BAR;
            PG8_LDB(B0, 1, 0); PG8_SCHED; PG8_LDA(At, 1, 0); PG8_STAGE(PG8_SA(0, 1), a2 + hstepA, voffA);
            PG8_WAIT_L(8); PG8_BAR; PG8_WAIT_L(0); PG8_MMA(0, 0, At, B0); PG8_BAR; PG8_SCHED;
            PG8_LDB(B1, 1, 1); PG8_STAGE(PG8_SB(1, 0), b3, voffB);
            PG8_BAR; PG8_WAIT_L(0); PG8_MMA(0, 1, At, B1); PG8_BAR;
            PG8_LDA(At, 1, 1); PG8_STAGE(PG8_SA(1, 0), a3, voffA);
            PG8_BAR; PG8_WAIT_L(0); PG8_MMA(1, 0, At, B0); PG8_BAR; PG8_SCHED;
            PG8_STAGE(PG8_SB(1, 1), b3 + hstepB, voffB);
            PG8_WAIT_V(6); PG8_BAR; PG8_MMA(1, 1, At, B1); PG8_BAR;
            }
          }
        }
        if constexpr (ALIGN_EPI) { if (wr == 0) PG8_BAR; }
        E(acc, cur, wr, wc, fr, fq);
        if (!has_next) break;
        if (!Epi::keeps_acc(cur)) {
#pragma unroll
        for (int a = 0; a < 2; ++a)
#pragma unroll
            for (int b = 0; b < 2; ++b)
#pragma unroll
                for (int m = 0; m < 4; ++m)
#pragma unroll
                    for (int n = 0; n < 2; ++n) acc[a][b][m][n] = (f32x4){0.f, 0.f, 0.f, 0.f};
        }
        cur = nxt; cA = nA; cB = nB; ++ui;
        if constexpr (Epi::KHOOK) hkb = E.hook_base(cur);
        if constexpr (Epi::LDS_CONST) { if (wid == 0) E.stage_consts(cur, lds, lane); }
        if constexpr (ALIGN_EPI) { if (wr == 1) PG8_BAR; }
    }
    PG8_WAIT_V(0);
    if constexpr (!ALIGN_EPI) { if (wr == 0) PG8_BAR; }
    PG8_BAR;
#undef PG8_SA
#undef PG8_SB
#undef PG8_STAGE
#undef PG8_LDA
#undef PG8_LDB
#undef PG8_MMA
#undef PG8_WAIT_V
#undef PG8_WAIT_L
#undef PG8_BAR
#undef PG8_SCHED
}


struct EpiInProj {
    static __device__ __forceinline__ bool keeps_acc(const Unit&) { return false; }
    static constexpr bool PERM = true; static constexpr bool LDS_CONST = true; static constexpr bool KHOOK = false;
    bf16_t *Q, *Kr, *KT, *VT, *OG, *ZA, *HB, *GA, *GB; const float* bias; const float* convw; float* SB; int ldhb; LAS unsigned char* tlds;
    __device__ __forceinline__ void stage_consts(const Unit& u, LAS unsigned char* lds, int lane) const {
        LAS unsigned char* cb = tlds + 9216 + 2048 * u.par;
        __builtin_amdgcn_global_load_lds((const unsigned*)(bias + u.pn * BM + 4 * lane), (LAS unsigned*)cb, 16, 0, 0);
        if (u.pn >= 32 && u.pn < 64) {
#pragma unroll
            for (int tap = 0; tap < 3; ++tap) __builtin_amdgcn_global_load_lds((const unsigned*)(convw + tap * 2048 + 64 * (u.pn - 32) + lane), (LAS unsigned*)(cb + 1024 + 256 * tap), 4, 0, 0);
        }
        (void)lds;
    }
    __device__ __forceinline__ void operator()(f32x4 (&acc)[2][2][4][2], const Unit& u, int wr, int wc, int fr, int fq) const {
        const int pn = u.pn;
        const LAS float* cbias = (const LAS float*)(tlds + 9216 + 2048 * u.par) + wc * 32 + 8 * fq;
        const LAS float* ctap = (const LAS float*)(tlds + 9216 + 2048 * u.par + 1024) + 16 * wc + 4 * fq;
        const int row0 = u.pm * BM + wr * 64 + fr;
        const int bcol0 = pn * BM + wc * 32 + 8 * fq;
        if (pn >= 32 && pn < 64) {
            const int ch0 = 64 * (pn - 32) + 16 * wc + 4 * fq;
            const f32x4 w0 = *(const LAS f32x4*)(ctap), w1 = *(const LAS f32x4*)(ctap + 64), w2 = *(const LAS f32x4*)(ctap + 128);
            const f32x4 bu = *(const LAS f32x4*)(cbias), bB = *(const LAS f32x4*)(cbias + 4), bC = *(const LAS f32x4*)(cbias + HALF), bz = *(const LAS f32x4*)(cbias + HALF + 4);
            const int lane = fq * 16 + fr;
#pragma unroll
            for (int ai = 0; ai < 2; ++ai) {
                f32x4 pr1 = (f32x4){0.f, 0.f, 0.f, 0.f}, pr2 = pr1;
                const int g = u.pm * 4 + ai * 2 + wr;
                float* sb = SB + (size_t)g * 6 * 2048 + ch0;
#pragma unroll
                for (int m = 0; m < 4; ++m) {
                    const f32x4 uu = acc[ai][0][m][0] + bu, Bv = acc[ai][0][m][1] + bB, Cv = acc[ai][1][m][0] + bC, zb = acc[ai][1][m][1] + bz;
                    f32x4 cu, bzv, r1, r2, p1, p2, hb;
#pragma unroll
                    for (int e = 0; e < 4; ++e) { cu[e] = Cv[e] * uu[e]; bzv[e] = Bv[e] * silu_f(zb[e]); }
#pragma unroll
                    for (int e = 0; e < 4; ++e) { r1[e] = __int_as_float(__builtin_amdgcn_update_dpp(0, __float_as_int(cu[e]), 0x121, 0xf, 0xf, false)); r2[e] = __int_as_float(__builtin_amdgcn_update_dpp(0, __float_as_int(cu[e]), 0x122, 0xf, 0xf, false)); }
#pragma unroll
                    for (int e = 0; e < 4; ++e) { p1[e] = fr >= 1 ? r1[e] : pr1[e]; p2[e] = fr >= 2 ? r2[e] : pr2[e]; }
                    const f32x4 cv = w0 * p2 + w1 * p1 + w2 * cu;
                    hb = bzv * cv;
                    u32x2 w; w.x = pk_bf16(hb[0], hb[1]); w.y = pk_bf16(hb[2], hb[3]);
                    *(u32x2*)(HB + ktm((size_t)(row0 + ai * HALF + m * 16), 2048 + ch0, 64)) = w;
                    if (m == 0 && fr < 2) { *(f32x4*)(sb + (2 + fr) * 2048) = bzv; *(f32x4*)(sb + (4 + fr) * 2048) = cv; }
                    if (m == 3 && fr >= 14) { *(f32x4*)(sb + (fr - 14) * 2048) = cu; }
                    pr1 = r1; pr2 = r2;
                }
            }
            return;
        }
        int kind, colt, act = 0; float sc = 1.f; bf16_t* dst = nullptr; bf16_t* dstT = nullptr;
        if (pn < 4) { kind = 0; dst = Q; colt = pn * BM; sc = 0.08838834764831845f; }
        else if (pn < 8) { kind = 1; dst = Kr; dstT = KT; colt = (pn - 4) * BM; }
        else if (pn < 16) { kind = 2; dstT = VT; colt = (pn - 8) * BM; }
        else if (pn < 24) { kind = 3; dst = OG; colt = (pn - 16) * BM; act = 1; }
        else if (pn < 32) { kind = 4; dst = ZA; colt = (pn - 24) * BM; act = 2; }
        else {
            const int ch0 = 128 * (pn - 64) + wc * 32 + 8 * fq;
            f32x4 ba[2], bb[2];
#pragma unroll
            for (int n = 0; n < 2; ++n) { ba[n] = *(const LAS f32x4*)(cbias + 4 * n); bb[n] = *(const LAS f32x4*)(cbias + HALF + 4 * n); }
#pragma unroll
            for (int ai = 0; ai < 2; ++ai)
#pragma unroll
                for (int m = 0; m < 4; ++m) {
                    const size_t off = ((((((size_t)(u.pm * 2 + ai) * 2 + wr) * 4 + m) * 16 + (pn - 64)) * 4 + wc) * 64 + fq * 16 + fr) * 8;
                    float rr[8], gg[8];
#pragma unroll
                    for (int n = 0; n < 2; ++n)
#pragma unroll
                        for (int e = 0; e < 4; ++e) {
                            const float ea = __builtin_amdgcn_exp2f((acc[ai][0][m][n][e] + ba[n][e]) * -1.4426950408889634f), eb = __builtin_amdgcn_exp2f((acc[ai][1][m][n][e] + bb[n][e]) * -1.4426950408889634f);
                            rr[4 * n + e] = (1.f + eb) * __builtin_amdgcn_rcpf(1.f + ea); gg[4 * n + e] = __builtin_amdgcn_rcpf(1.f + eb);
                        }
                    u32x4 wr_, wg_;
                    wr_.x = pk_bf16(rr[0], rr[1]); wr_.y = pk_bf16(rr[2], rr[3]); wr_.z = pk_bf16(rr[4], rr[5]); wr_.w = pk_bf16(rr[6], rr[7]);
                    wg_.x = pk_bf16(gg[0], gg[1]); wg_.y = pk_bf16(gg[2], gg[3]); wg_.z = pk_bf16(gg[4], gg[5]); wg_.w = pk_bf16(gg[6], gg[7]);
                    *(u32x4*)(GA + off) = wr_; *(u32x4*)(GB + off) = wg_;
                }
            return;
        }
        const int col0 = colt + wc * 32 + 8 * fq;
        f32x4 bv[2][2];
#pragma unroll
        for (int bj = 0; bj < 2; ++bj)
#pragma unroll
            for (int n = 0; n < 2; ++n) bv[bj][n] = *(const LAS f32x4*)(cbias + bj * HALF + 4 * n);
        if (kind != 2) {
#pragma unroll
        for (int ai = 0; ai < 2; ++ai)
#pragma unroll
            for (int m = 0; m < 4; ++m) {
                const int row = row0 + ai * HALF + m * 16;
                const int cidx = row >> 6, tau = row & 63;
#pragma unroll
                for (int bj = 0; bj < 2; ++bj) {
                    f32x4 v0 = acc[ai][bj][m][0] + bv[bj][0], v1 = acc[ai][bj][m][1] + bv[bj][1];
                    if (act == 1) {
#pragma unroll
                        for (int e = 0; e < 4; ++e) { v0[e] = sigmoid_f(v0[e]); v1[e] = sigmoid_f(v1[e]); }
                    } else if (act == 2) {
#pragma unroll
                        for (int e = 0; e < 4; ++e) { v0[e] = silu_f(v0[e]); v1[e] = silu_f(v1[e]); }
                    } else { v0 = v0 * sc; v1 = v1 * sc; }
                    u32x4 w; w.x = pk_bf16(v0[0], v0[1]); w.y = pk_bf16(v0[2], v0[3]); w.z = pk_bf16(v1[0], v1[1]); w.w = pk_bf16(v1[2], v1[3]);
                    const int c0 = col0 + bj * HALF;
                    if (kind <= 1) {
                        const int hh = c0 >> 7, dk0 = c0 & 127;
                        const size_t fi = ((((size_t)((cidx >> 6) * 8 + hh) * 64 + (cidx & 63)) * 2 + (tau >> 5)) * 8 + (dk0 >> 4)) * 64 + ((dk0 >> 3) & 1) * 32 + (tau & 31);
                        *(u32x4*)(dst + fi * 8) = w;
                    } else {
                        const int hh = c0 >> 8, d8 = (c0 & 255) >> 3;
                        const size_t fi = ((((size_t)((cidx >> 6) * 8 + hh) * 64 + (cidx & 63)) * 2 + (tau >> 5)) * 32 + d8) * 64 + (tau & 31);
                        *(u32x2*)(dst + fi * 4) = (u32x2){w.x, w.y}; *(u32x2*)(dst + (fi + 32) * 4) = (u32x2){w.z, w.w};
                    }
                }
            }
        }
        if (kind == 1 || kind == 2) {
            const int hshift = kind == 1 ? 7 : 8, nblk = kind == 1 ? 4 : 8;
            const int lane = fq * 16 + fr;
            LAS unsigned char* my = tlds + (wr * 4 + wc) * 1152;
            LAS unsigned char* wp = my + (4 * fq) * 72 + fr * 2;
            const LAS unsigned char* rp = my + (lane >> 2) * 72 + ((lane >> 1) & 1) * 32 + (lane & 1) * 8;
            const int ccol0 = colt + wc * 32 + 8 * (lane >> 4) + ((lane >> 2) & 3);
            const int rrow0 = u.pm * BM + wr * 64;
#pragma unroll
            for (int ai = 0; ai < 2; ++ai)
#pragma unroll
                for (int bj = 0; bj < 2; ++bj)
#pragma unroll
                    for (int n = 0; n < 2; ++n)
#pragma unroll
                        for (int mp = 0; mp < 2; ++mp) {
#pragma unroll
                            for (int mm = 0; mm < 2; ++mm) {
                                const f32x4 v = acc[ai][bj][2 * mp + mm][n] + bv[bj][n];
                                const unsigned p01 = pk_bf16(v[0], v[1]), p23 = pk_bf16(v[2], v[3]);
                                *(LAS unsigned short*)(wp + 0 * 72 + 32 * mm) = (unsigned short)(p01 & 0xffffu); *(LAS unsigned short*)(wp + 1 * 72 + 32 * mm) = (unsigned short)(p01 >> 16);
                                *(LAS unsigned short*)(wp + 2 * 72 + 32 * mm) = (unsigned short)(p23 & 0xffffu); *(LAS unsigned short*)(wp + 3 * 72 + 32 * mm) = (unsigned short)(p23 >> 16);
                            }
                            asm volatile("" ::: "memory");
                            const u32x2 lo = *(const LAS u32x2*)(rp), hi = *(const LAS u32x2*)(rp + 16);
                            asm volatile("" ::: "memory");
                            const int rr = rrow0 + ai * HALF + 32 * mp, cidx = rr >> 6, ks = ((rr & 63) >> 4) + ((lane >> 1) & 1);
                            const int cc = ccol0 + bj * HALF + 4 * n, hh = cc >> hshift, rowi = cc & ((1 << hshift) - 1);
                            const size_t fi = ((((size_t)((cidx >> 6) * 8 + hh) * 64 + (cidx & 63)) * nblk + (rowi >> 5)) * 4 + ks) * 64 + (lane & 1) * 32 + (rowi & 31);
                            *(u32x4*)(dstT + fi * 8) = (u32x4){lo.x, lo.y, hi.x, hi.y};
                        }
        }
    }
};

struct MergeOrder {
    StaticOrder so;
    __device__ bool next(int i, Unit& u) const { if (!so.next(i >> 1, u)) return false; u.which = i & 1; return true; }
};
struct EpiMerge {
    static __device__ __forceinline__ bool keeps_acc(const Unit& u) { return u.which == 0; }
    static constexpr bool PERM = true; static constexpr bool LDS_CONST = false; static constexpr bool KHOOK = false;
    const bf16_t* RR; const bf16_t* GB; bf16_t* MG;
    __device__ __forceinline__ void operator()(f32x4 (&acc)[2][2][4][2], const Unit& u, int wr, int wc, int fr, int fq) const {
        const int row0 = u.pm * BM + wr * 64 + fr, col0 = u.pn * BM + wc * 32 + 8 * fq;
        const bf16_t* src = u.which == 0 ? RR : GB;
        u32x4 gv[2][4][2];
#pragma unroll
        for (int ai = 0; ai < 2; ++ai)
#pragma unroll
            for (int m = 0; m < 4; ++m)
#pragma unroll
                for (int bj = 0; bj < 2; ++bj) gv[ai][m][bj] = *(const u32x4*)(src + ((((((size_t)(u.pm * 2 + ai) * 2 + wr) * 4 + m) * 16 + (2 * u.pn + bj)) * 4 + wc) * 64 + fq * 16 + fr) * 8);
        asm volatile("" ::: "memory");
#pragma unroll
        for (int ai = 0; ai < 2; ++ai)
#pragma unroll
            for (int m = 0; m < 4; ++m) {
#pragma unroll
                for (int bj = 0; bj < 2; ++bj) {
                    const size_t off = ktm((size_t)(row0 + ai * HALF + m * 16), col0 + bj * HALF, 32);
                    const u32x4 g = gv[ai][m][bj];
                    f32x4 g0 = {bf_lo(g.x), bf_hi(g.x), bf_lo(g.y), bf_hi(g.y)}, g1 = {bf_lo(g.z), bf_hi(g.z), bf_lo(g.w), bf_hi(g.w)};
                    const f32x4 t0 = acc[ai][bj][m][0] * g0, t1 = acc[ai][bj][m][1] * g1;
                    if (u.which == 0) { acc[ai][bj][m][0] = t0; acc[ai][bj][m][1] = t1; }
                    else { u32x4 w; w.x = pk_bf16(t0[0], t0[1]); w.y = pk_bf16(t0[2], t0[3]); w.z = pk_bf16(t1[0], t1[1]); w.w = pk_bf16(t1[2], t1[3]); *(u32x4*)(MG + off) = w; }
                }
            }
    }
};
struct PanelOrder {
    int vcu;
    __device__ bool next(int i, Unit& u) const { if (i >= 2) return false; u.pm = 32 * i + (vcu >> 3); u.pn = vcu & 7; u.which = 0; return true; }
};
struct EpiOutNorm {
    static __device__ __forceinline__ bool keeps_acc(const Unit&) { return false; }
    static constexpr bool PERM = false; static constexpr bool LDS_CONST = false; static constexpr bool KHOOK = true;
    const float* X; const float* gate; const float* nfw; float* O; float* rowss; unsigned* cnt;
    __device__ __forceinline__ const float* hook_base(const Unit& u) const { return X + (size_t)(u.pm * BM) * DM + u.pn * BM; }
    __device__ __forceinline__ void operator()(f32x4 (&acc)[2][2][4][2], const Unit& u, int wr, int wc, int fr, int fq) const {
        asm volatile("" : "+v"(fr), "+v"(fq));
        const int row0 = u.pm * BM + wr * 64 + fr, col0 = u.pn * BM + wc * 32 + 4 * fq;
        float rs[2][4];
#pragma unroll
        for (int ai = 0; ai < 2; ++ai)
#pragma unroll
            for (int m = 0; m < 4; ++m) {
                float q = 0.f;
#pragma unroll
                for (int bj = 0; bj < 2; ++bj)
#pragma unroll
                    for (int n = 0; n < 2; ++n) { const f32x4 v = acc[ai][bj][m][n]; q += (v[0] * v[0] + v[1] * v[1]) + (v[2] * v[2] + v[3] * v[3]); }
                q += __shfl_xor(q, 16); q += __shfl_xor(q, 32);
                rs[ai][m] = q;
            }
        float sink = 0.f;
        if (fq == 0) {
#pragma unroll
            for (int ai = 0; ai < 2; ++ai)
#pragma unroll
                for (int m = 0; m < 4; ++m) sink += __hip_atomic_fetch_add(rowss + row0 + ai * HALF + m * 16, rs[ai][m], __ATOMIC_RELAXED, __HIP_MEMORY_SCOPE_AGENT);
        }
        asm volatile("s_waitcnt vmcnt(0)" :: "v"(sink) : "memory");
        unsigned* cp = cnt + 64 * u.pm;
        if (fq == 0 && fr == 0) (void)__hip_atomic_fetch_add(cp, 1u, __ATOMIC_RELAXED, __HIP_MEMORY_SCOPE_AGENT);
        {
            unsigned spins = 0;
            while ((unsigned)__builtin_amdgcn_readfirstlane(__hip_atomic_load(cp, __ATOMIC_RELAXED, __HIP_MEMORY_SCOPE_AGENT)) < 64u) { __builtin_amdgcn_s_sleep(2); if (++spins > (1u << 22)) break; }
        }
        asm volatile("" ::: "memory");
        float rstd[2][4];
#pragma unroll
        for (int ai = 0; ai < 2; ++ai)
#pragma unroll
            for (int m = 0; m < 4; ++m) rstd[ai][m] = rsqrtf(__hip_atomic_load(rowss + row0 + ai * HALF + m * 16, __ATOMIC_RELAXED, __HIP_MEMORY_SCOPE_AGENT) * (1.f / DM) + EPS);
        f32x4 wv[2][2];
#pragma unroll
        for (int bj = 0; bj < 2; ++bj)
#pragma unroll
            for (int n = 0; n < 2; ++n) wv[bj][n] = *(const f32x4*)(nfw + col0 + bj * HALF + n * 16);
        const bool lo8 = fr < 8;
        float* oA = O + (size_t)(u.pm * BM + wr * 64 + (fr & 7)) * DM + u.pn * BM + wc * 32 + 4 * fq + (lo8 ? 0 : 16);
        float* oB = O + (size_t)(u.pm * BM + wr * 64 + 8 + (fr & 7)) * DM + u.pn * BM + wc * 32 + 4 * fq + (lo8 ? 16 : 0);
#pragma unroll
        for (int ai = 0; ai < 2; ++ai)
#pragma unroll
            for (int m = 0; m < 4; ++m) {
                const size_t off = (size_t)(ai * HALF + m * 16) * DM;
#pragma unroll
                for (int bj = 0; bj < 2; ++bj) {
                    const f32x4 v0 = acc[ai][bj][m][0] * rstd[ai][m] * wv[bj][0], v1 = acc[ai][bj][m][1] * rstd[ai][m] * wv[bj][1];
                    const f32x4 t1 = ror8(v1);
                    f32x4 dA, dB;
#pragma unroll
                    for (int e = 0; e < 4; ++e) { dA[e] = lo8 ? v0[e] : t1[e]; dB[e] = lo8 ? t1[e] : v0[e]; }
                    *(f32x4*)(oA + off + bj * HALF) = dA; *(f32x4*)(oB + off + bj * HALF) = dB;
                }
            }
    }
};
}

constexpr size_t MiB = 1u << 20;
constexpr size_t WS_CTL = 0, CTL_ZERO_BYTES = 73728 * 4;
constexpr size_t WS_MISC = 1 * MiB;
constexpr size_t WS_WINT = 8 * MiB;
constexpr size_t WS_H = 88 * MiB;
constexpr size_t WS_CT = 8 * MiB;
constexpr size_t WS_MG = 8 * MiB;
constexpr size_t WS_WAB = 152 * MiB;
constexpr size_t WS_WO = 168 * MiB;
constexpr size_t WS_Q = 176 * MiB, WS_K = 208 * MiB, WS_VT = 240 * MiB, WS_KT = 304 * MiB;
constexpr size_t WS_OG = 336 * MiB, WS_ZA = 400 * MiB, WS_HAB = 464 * MiB;
constexpr size_t WS_SB = 592 * MiB;
constexpr size_t WS_WOS = 604 * MiB;
constexpr size_t WS_END = 636 * MiB;
constexpr int CW_BAR = 0;
constexpr int CW_MOD = 28672;
constexpr int CW_ROWSS = 53248;
constexpr int CW_CNT = 69632;
constexpr size_t MI_BPERM = 0;
constexpr size_t MI_AMX = 32768, MI_GS = MI_AMX + 4096, MI_MS = MI_GS + 4096;
constexpr size_t MI_AA = 65536, MI_CM = MI_AA + 131072, MI_BB = MI_CM + 131072;
constexpr size_t MI_NJ = MI_BB + 131072;
constexpr size_t MI_WIF = MI_NJ + 262144;
static_assert((MI_WIF + 32768) * 4 <= 7 * MiB, "misc map");

constexpr int NWAVES = 8;
constexpr int LDS_BYTES = 147456;

#define GAS __attribute__((address_space(1)))
typedef GAS unsigned gu32;
#define RLX_AGENT __ATOMIC_RELAXED, __HIP_MEMORY_SCOPE_AGENT

#define XB_TMO      128
#define XB_XCNT(j)  (256  + 64 * (j))
#define XB_XSUB(j)  (1280 + 64 * (j))
#define XB_XGEN(j)  (2304 + 64 * (j))
#define XB_TOP      3328
#define XB_TOPGEN   3392
#define XCD_BAR_WORDS 3456
#define XB_SPIN_CAP (1u << 18)
__device__ __forceinline__ unsigned xb_ld(unsigned* p)              { return __hip_atomic_load(p, __ATOMIC_RELAXED, __HIP_MEMORY_SCOPE_AGENT); }
__device__ __forceinline__ unsigned xb_add(unsigned* p, unsigned v) { return __hip_atomic_fetch_add(p, v, __ATOMIC_RELAXED, __HIP_MEMORY_SCOPE_AGENT); }
__device__ __forceinline__ unsigned xb_xcc_id() { return (unsigned)__builtin_amdgcn_s_getreg((3 << 11) | 20) & 0xFu; }
#define XB_SPIN(cond, bar) do { unsigned _sp = 0; while (cond) { __builtin_amdgcn_s_sleep(1); \
    if ((++_sp & 255u) == 0u) { if (xb_ld(&(bar)[XB_TMO])) break; if (_sp > XB_SPIN_CAP) { atomicAdd(&(bar)[XB_TMO], 1u); break; } } } } while (0)
struct XcdBarrier { unsigned* bar; unsigned x; volatile LAS unsigned* st; };
__device__ __forceinline__ XcdBarrier xcd_barrier_post(unsigned* bar, volatile LAS unsigned* st) {
    XcdBarrier b; b.bar = bar; b.x = xb_xcc_id(); b.st = st;
    if (threadIdx.x == 0) (void)xb_add(&bar[XB_XCNT(b.x)], 1u);
    return b;
}
__device__ __forceinline__ void xcd_barrier_complete(unsigned* bar, unsigned x, unsigned& nloc, unsigned& nx) {
    const unsigned G = gridDim.x * gridDim.y * gridDim.z;
    unsigned sum, cnt, mine, sp = 0u;
    for (;;) {
        sum = 0u; cnt = 0u; mine = 0u;
#pragma unroll
        for (unsigned j = 0; j < 16; ++j) { const unsigned c = xb_ld(&bar[XB_XCNT(j)]); sum += c; cnt += (c > 0u) ? 1u : 0u; mine = (j == x) ? c : mine; }
        if (sum == G) break;
        __builtin_amdgcn_s_sleep(1);
        if ((++sp & 255u) == 0u) { if (xb_ld(&bar[XB_TMO])) break; if (sp > XB_SPIN_CAP) { atomicAdd(&bar[XB_TMO], 1u); break; } }
    }
    nloc = mine > 0u ? mine : 1u; nx = cnt > 0u ? cnt : 1u;
}
__device__ __forceinline__ void xcd_barrier(const XcdBarrier& b) {
    asm volatile("s_waitcnt vmcnt(0)" ::: "memory");
    __syncthreads();
    if (threadIdx.x == 0) {
        unsigned* bar = b.bar;
        __builtin_amdgcn_s_waitcnt(0);
        unsigned nloc = b.st[0], nx = b.st[1];
        if (nloc == 0u) { xcd_barrier_complete(bar, b.x, nloc, nx); b.st[0] = nloc; b.st[1] = nx; }
        const unsigned old = xb_add(&bar[XB_XSUB(b.x)], 1u);
        const unsigned gen = old / nloc;
        if (old + 1u == (gen + 1u) * nloc) {
            __builtin_amdgcn_fence(__ATOMIC_RELEASE, "agent");
            asm volatile("s_waitcnt vmcnt(0)" ::: "memory");
            const unsigned og = xb_add(&bar[XB_TOP], 1u);
            const unsigned tg = og / nx;
            if (og + 1u == (tg + 1u) * nx) xb_add(&bar[XB_TOPGEN], 1u);
            else XB_SPIN(xb_ld(&bar[XB_TOPGEN]) == tg, bar);
            __builtin_amdgcn_fence(__ATOMIC_ACQUIRE, "agent");
            xb_add(&bar[XB_XGEN(b.x)], 1u);
            asm volatile("s_waitcnt vmcnt(0)" ::: "memory");
        } else {
            XB_SPIN(xb_ld(&bar[XB_XGEN(b.x)]) == gen, bar);
            __builtin_amdgcn_fence(__ATOMIC_ACQUIRE, "agent");
            asm volatile("s_waitcnt vmcnt(0)" ::: "memory");
        }
    }
    __syncthreads();
}

struct Args { const float* in[13]; float* out; unsigned char* ws; int ph_lo, ph_hi, li, pad; };

template <class ColFn>
__device__ __forceinline__ void p0_transpose_item(const float* W, int ldw, bf16_t* WT, int ldt, int koff, int k0, int n0, ColFn colfn, LAS float* scr, int lane) {
    const int sc = colfn(n0 + 4 * (lane & 7));
    f32x4 v[8];
#pragma unroll
    for (int i = 0; i < 8; ++i) v[i] = *(const f32x4*)(W + (size_t)(k0 + 8 * i + (lane >> 3)) * ldw + sc);
#pragma unroll
    for (int i = 0; i < 8; ++i) { LAS float* d = scr + (8 * i + (lane >> 3)) * 33 + 4 * (lane & 7); d[0] = v[i][0]; d[1] = v[i][1]; d[2] = v[i][2]; d[3] = v[i][3]; }
    asm volatile("s_waitcnt lgkmcnt(0)" ::: "memory");
    const int c = lane & 7;
#pragma unroll
    for (int j = 0; j < 4; ++j) { const int n = (lane >> 3) + 8 * j; const LAS float* s = scr + (8 * c) * 33 + n;
        u32x4 o; o.x = pk_bf16(s[0 * 33], s[1 * 33]); o.y = pk_bf16(s[2 * 33], s[3 * 33]); o.z = pk_bf16(s[4 * 33], s[5 * 33]); o.w = pk_bf16(s[6 * 33], s[7 * 33]);
        *(u32x4*)(WT + (size_t)(n0 + n) * ldt + koff + k0 + 8 * c) = o; }
    asm volatile("s_waitcnt lgkmcnt(0)" ::: "memory");
}

struct P0Item { const float* src; bf16_t* dst; int ldw, ldt; };
__device__ __forceinline__ P0Item p0_item(const Args& a, unsigned char* ws, int it, int lane) {
    constexpr int I_IN = 32 * 640, I_SQ = 32 * 64;
    P0Item p;
    if (it < I_IN) {
        const int kb = it / 640, nb = it % 640;
        p.src = a.in[5] + (size_t)(64 * kb) * INW + win_src_col(32 * nb + 4 * (lane & 7)); p.ldw = INW;
        p.dst = (bf16_t*)(ws + WS_WINT) + pg8::ktm((size_t)(32 * nb), 64 * kb, 32); p.ldt = 64;
    } else {
        const int r0 = it - I_IN, mat = r0 / I_SQ, r = r0 % I_SQ, kb = r / 64, nb = r % 64;
        const float* W = mat == 0 ? a.in[9] : a.in[10];
        p.src = W + (size_t)(64 * kb) * DM + 32 * nb + 4 * (lane & 7); p.ldw = DM;
        p.ldt = 64;
        p.dst = (bf16_t*)(ws + WS_WAB) + pg8::ktm((size_t)(32 * nb), (mat == 1 ? 2048 : 0) + 64 * kb, 64);
    }
    return p;
}
__device__ __forceinline__ void p0_item_load(const P0Item& p, f32x4 (&v)[8], int lane) {
#pragma unroll
    for (int i = 0; i < 8; ++i) v[i] = *(const f32x4*)(p.src + (size_t)(8 * i + (lane >> 3)) * p.ldw);
}
__device__ __forceinline__ void p0_item_finish(const P0Item& p, const f32x4 (&v)[8], LAS float* scr, int lane) {
#pragma unroll
    for (int i = 0; i < 8; ++i) { LAS float* d = scr + (8 * i + (lane >> 3)) * 33 + 4 * (lane & 7); d[0] = v[i][0]; d[1] = v[i][1]; d[2] = v[i][2]; d[3] = v[i][3]; }
    asm volatile("s_waitcnt lgkmcnt(0)" ::: "memory");
    const int c = lane & 7;
#pragma unroll
    for (int j = 0; j < 4; ++j) { const int n = (lane >> 3) + 8 * j; const LAS float* sp = scr + (8 * c) * 33 + n;
        u32x4 o; o.x = pk_bf16(sp[0 * 33], sp[1 * 33]); o.y = pk_bf16(sp[2 * 33], sp[3 * 33]); o.z = pk_bf16(sp[4 * 33], sp[5 * 33]); o.w = pk_bf16(sp[6 * 33], sp[7 * 33]);
        *(u32x4*)(p.dst + (size_t)n * p.ldt + 8 * c) = o; }
    asm volatile("s_waitcnt lgkmcnt(0)" ::: "memory");
}

__device__ __forceinline__ void p0_prep(const Args& a, LAS unsigned char* lds, int tid, int lane, int wave, int vcu, int G) {
    unsigned char* ws = a.ws;
    const float* c_in = a.in[1]; const float* w_ada = a.in[3]; const float* b_ada = a.in[4]; const float* w_in = a.in[5]; const float* b_in = a.in[6];
    float* MOD = (float*)(ws + WS_CTL) + CW_MOD;
    {
        const int bx = blockIdx.x, cg = bx & 7, ks = bx >> 3;
        if (ks < 32) {
            LAS float* cact = (LAS float*)(lds + 100 * 1024);
            if (tid < 256) { const int b = tid >> 6, kk = tid & 63; cact[tid] = silu_acc(c_in[b * DM + ks * 64 + kk]); }
            f32x4 wv[8][3];
#pragma unroll
            for (int kk = 0; kk < 8; ++kk)
#pragma unroll
                for (int j = 0; j < 3; ++j) wv[kk][j] = *(const f32x4*)(w_ada + (size_t)(ks * 64 + wave * 8 + kk) * 6144 + cg * 768 + 256 * j + 4 * lane);
            __syncthreads();
            f32x4 acc[4][3];
#pragma unroll
            for (int b = 0; b < 4; ++b)
#pragma unroll
                for (int j = 0; j < 3; ++j) acc[b][j] = (f32x4){0.f, 0.f, 0.f, 0.f};
#pragma unroll
            for (int kk = 0; kk < 8; ++kk) {
                float ca[4];
#pragma unroll
                for (int b = 0; b < 4; ++b) ca[b] = cact[b * 64 + wave * 8 + kk];
#pragma unroll
                for (int j = 0; j < 3; ++j)
#pragma unroll
                    for (int b = 0; b < 4; ++b) acc[b][j] += wv[kk][j] * ca[b];
            }
            LAS f32x4* red = (LAS f32x4*)lds;
#pragma unroll
            for (int b = 0; b < 4; ++b)
#pragma unroll
                for (int j = 0; j < 3; ++j) red[(wave * 12 + b * 3 + j) * 64 + lane] = acc[b][j];
            __syncthreads();
            for (int idx = tid; idx < 768; idx += 512) {
                const int bj = idx >> 6, ln = idx & 63, b = bj / 3, j = bj % 3;
                f32x4 s = (f32x4){0.f, 0.f, 0.f, 0.f};
#pragma unroll
                for (int w = 0; w < 8; ++w) s += red[(w * 12 + bj) * 64 + ln];
                const int col = cg * 768 + 256 * j + 4 * ln;
                if (ks == 0) s += *(const f32x4*)(b_ada + col);
                float* mp = MOD + b * 6144 + col;
                atomicAdd(mp + 0, s[0]); atomicAdd(mp + 1, s[1]); atomicAdd(mp + 2, s[2]); atomicAdd(mp + 3, s[3]);
            }
            __syncthreads();
        }
    }
    {
        LAS float* scr = (LAS float*)(lds + wave * 16384);
        const int gw = vcu * NWAVES + wave, NGW = G * NWAVES;
        constexpr int NITEMS = 32 * 640 + 2 * 32 * 64;
        if (NGW * 12 == NITEMS) {
            P0Item I0 = p0_item(a, ws, gw, lane), I1;
            f32x4 v0[8], v1[8];
            p0_item_load(I0, v0, lane);
#pragma unroll 1
            for (int k = 0; k < 10; k += 2) {
                I1 = p0_item(a, ws, gw + (k + 1) * NGW, lane); p0_item_load(I1, v1, lane); p0_item_finish(I0, v0, scr, lane);
                I0 = p0_item(a, ws, gw + (k + 2) * NGW, lane); p0_item_load(I0, v0, lane); p0_item_finish(I1, v1, scr, lane);
            }
            I1 = p0_item(a, ws, gw + 11 * NGW, lane); p0_item_load(I1, v1, lane); p0_item_finish(I0, v0, scr, lane);
            p0_item_finish(I1, v1, scr, lane);
        } else {
            for (int it = gw; it < NITEMS; it += NGW) { const P0Item I = p0_item(a, ws, it, lane); f32x4 v[8]; p0_item_load(I, v, lane); p0_item_finish(I, v, scr, lane); }
        }
        float* bperm = (float*)(ws + WS_MISC) + MI_BPERM;
        for (int i = blockIdx.x * 512 + tid; i < NPRJ; i += G * 512) bperm[i] = b_in[win_src_col(i)];
        float* wif = (float*)(ws + WS_MISC) + MI_WIF;
        for (int i = blockIdx.x * 512 + tid; i < 2048 * 16; i += G * 512) wif[i] = w_in[(size_t)(i >> 4) * INW + O_IF + (i & 15)];
    }
}

__device__ __forceinline__ void p1_hnorm(const Args& a, LAS unsigned char* lds, int tid, int lane, int wave, int G) {
    unsigned char* ws = a.ws;
    const float* x = a.in[0]; const float* nw = a.in[2]; const float* w_in = a.in[5]; const float* b_in = a.in[6];
    const float* MOD = (const float*)(ws + WS_CTL) + CW_MOD;
    bf16_t* Hb = (bf16_t*)(ws + WS_H);
    float* misc = (float*)(ws + WS_MISC);
    LAS f32x4* wl = (LAS f32x4*)lds;
    LAS float* gl = (LAS float*)(lds + 131072);
    for (int it = blockIdx.x * NWAVES + wave; it < 32 * 64; it += G * NWAVES) {
        const int kb = it / 64, nb = it % 64;
        LAS float* scr = (LAS float*)(lds + wave * 16384);
        const float* src = a.in[11] + (size_t)(64 * kb) * DM + 32 * nb + 4 * (lane & 7);
        f32x4 v[8];
#pragma unroll
        for (int i = 0; i < 8; ++i) v[i] = *(const f32x4*)(src + (size_t)(8 * i + (lane >> 3)) * DM);
        float gt[4][4];
#pragma unroll
        for (int j = 0; j < 4; ++j)
#pragma unroll
            for (int bb = 0; bb < 4; ++bb) gt[j][bb] = MOD[bb * 6144 + 4096 + 32 * nb + (lane >> 3) + 8 * j];
#pragma unroll
        for (int i = 0; i < 8; ++i) { LAS float* d = scr + (8 * i + (lane >> 3)) * 33 + 4 * (lane & 7); d[0] = v[i][0]; d[1] = v[i][1]; d[2] = v[i][2]; d[3] = v[i][3]; }
        asm volatile("s_waitcnt lgkmcnt(0)" ::: "memory");
        const int c = lane & 7;
#pragma unroll
        for (int j = 0; j < 4; ++j) {
            const int n = (lane >> 3) + 8 * j; const LAS float* sp = scr + (8 * c) * 33 + n;
            float e[8];
#pragma unroll
            for (int q = 0; q < 8; ++q) e[q] = sp[q * 33];
#pragma unroll
            for (int bb = 0; bb < 4; ++bb) {
                const float gg = gt[j][bb];
                u32x4 o; o.x = pk_bf16(e[0] * gg, e[1] * gg); o.y = pk_bf16(e[2] * gg, e[3] * gg); o.z = pk_bf16(e[4] * gg, e[5] * gg); o.w = pk_bf16(e[6] * gg, e[7] * gg);
                *(u32x4*)((bf16_t*)(ws + WS_WOS) + (size_t)bb * DM * DM + pg8::ktm((size_t)(32 * nb + n), 64 * kb + 8 * c, 32)) = o;
            }
        }
        asm volatile("s_waitcnt lgkmcnt(0)" ::: "memory");
    }
    __syncthreads();
    {
        const f32x4* wif4 = (const f32x4*)(misc + MI_WIF);
#pragma unroll 1
        for (int hb = 0; hb < 2; ++hb) {
            f32x4 wq[8];
#pragma unroll
            for (int i = 0; i < 8; ++i) wq[i] = wif4[tid + 512 * (8 * hb + i)];
#pragma unroll
            for (int i = 0; i < 8; ++i) { const int q4 = tid + 512 * (8 * hb + i), k = q4 >> 2, gq = q4 & 3, e = k & 3, l = (k >> 2) & 63, jx = k >> 8; wl[((e * 8 + jx) * 4 + gq) * 64 + l] = wq[i]; }
        }
    }
    __syncthreads();
    const int gw = blockIdx.x * NWAVES + wave;
    const int rbase = gw * 8, b = rbase >> 12;
    f32x4 ms[8], sh[8];
#pragma unroll
    for (int j = 0; j < 8; ++j) {
        const int k = 4 * lane + 256 * j;
        const f32x4 nv = *(const f32x4*)(nw + k), scv = *(const f32x4*)(MOD + b * 6144 + 2048 + k);
        ms[j] = nv * (scv + 1.0f); sh[j] = *(const f32x4*)(MOD + b * 6144 + k);
    }
    for (int i = 0; i < 8; ++i) {
        const int row = rbase + i;
        const f32x4* xr = (const f32x4*)(x + (size_t)row * DM) + lane;
        f32x4 v[8]; float ss = 0.f;
#pragma unroll
        for (int j = 0; j < 8; ++j) { v[j] = xr[64 * j]; ss += (v[j][0] * v[j][0] + v[j][1] * v[j][1]) + (v[j][2] * v[j][2] + v[j][3] * v[j][3]); }
        const float rstd = rsqrtf(wave_sum(ss) * (1.f / DM) + EPS);
        f32x4 acc[4];
#pragma unroll
        for (int gq = 0; gq < 4; ++gq) acc[gq] = (f32x4){0.f, 0.f, 0.f, 0.f};
        u32x2* hrow = (u32x2*)(Hb + (size_t)row * DM) + lane;
#pragma unroll
        for (int j = 0; j < 8; ++j) {
            const f32x4 hv = v[j] * rstd * ms[j] + sh[j];
            u32x2 w; w.x = pk_bf16(hv[0], hv[1]); w.y = pk_bf16(hv[2], hv[3]);
            hrow[64 * j] = w;
#pragma unroll
            for (int e = 0; e < 4; ++e)
#pragma unroll
                for (int gq = 0; gq < 4; ++gq) acc[gq] += wl[((e * 8 + j) * 4 + gq) * 64 + lane] * hv[e];
            asm volatile("" ::: "memory");
        }
        float mine = 0.f;
#pragma unroll
        for (int gq = 0; gq < 4; ++gq)
#pragma unroll
            for (int e = 0; e < 4; ++e) { const float sgs = wave_sum(acc[gq][e]); mine = (lane == gq * 4 + e) ? sgs : mine; }
        if (lane < 16) {
            const float pre = mine + b_in[O_IF + lane];
            gl[lane * 64 + wave * 8 + i] = lane < 8 ? pre : (fminf(pre, 0.f) - log1pf(expf(-fabsf(pre))));
        }
    }
    __syncthreads();
    {
        const int hh = wave, jc = blockIdx.x & 63, bh = b * 8 + hh;
        const float li = gl[hh * 64 + lane], lf = gl[(8 + hh) * 64 + lane];
        float bc = lf;
#pragma unroll
        for (int o = 1; o < 64; o <<= 1) { const float t = __shfl_up(bc, o); if (lane >= o) bc += t; }
        const float av = li - bc;
        float cm = av;
#pragma unroll
        for (int o = 1; o < 64; o <<= 1) { const float t = __shfl_up(cm, o); if (lane >= o) cm = fmaxf(cm, t); }
        const size_t ti = (size_t)bh * SEQ + jc * 64 + lane;
        misc[MI_AA + ti] = av; misc[MI_CM + ti] = cm; misc[MI_BB + ti] = bc;
        if (lane == 63) { misc[MI_AMX + bh * 64 + jc] = cm; misc[MI_GS + bh * 64 + jc] = bc; }
    }
}

__device__ __forceinline__ f32x16 mfma32(bf16x8 a, bf16x8 b, f32x16 c) { return MFMA32(a, b, c); }

__device__ __forceinline__ void p3_scan(const Args& a, LAS unsigned char* lds, int tid, int lane, int wave, int vcu, int G) {
    unsigned char* ws = a.ws;
    {
        const float* SB = (const float*)(ws + WS_SB); const float* convw = a.in[7]; bf16_t* HB = (bf16_t*)(ws + WS_HAB);
        for (int idx = blockIdx.x * 512 + tid; idx < 256 * 512; idx += G * 512) {
            const int g = idx >> 9, ch = (idx & 511) * 4;
            const float* sb = SB + (size_t)g * 6 * 2048 + ch;
            f32x4 c62 = (f32x4){0.f, 0.f, 0.f, 0.f}, c63 = c62;
            if ((g & 63) != 0) { c62 = *(const f32x4*)(sb - 6 * 2048); c63 = *(const f32x4*)(sb - 5 * 2048); }
            const f32x4 bz0 = *(const f32x4*)(sb + 2 * 2048), bz1 = *(const f32x4*)(sb + 3 * 2048), p0 = *(const f32x4*)(sb + 4 * 2048), p1 = *(const f32x4*)(sb + 5 * 2048);
            const f32x4 w0 = *(const f32x4*)(convw + ch), w1 = *(const f32x4*)(convw + 2048 + ch);
            const f32x4 h0 = bz0 * (p0 + w0 * c62 + w1 * c63), h1 = bz1 * (p1 + w0 * c63);
            u32x2 o0, o1; o0.x = pk_bf16(h0[0], h0[1]); o0.y = pk_bf16(h0[2], h0[3]); o1.x = pk_bf16(h1[0], h1[1]); o1.y = pk_bf16(h1[2], h1[3]);
            *(u32x2*)(HB + pg8::ktm((size_t)(64 * g), 2048 + ch, 64)) = o0; *(u32x2*)(HB + pg8::ktm((size_t)(64 * g + 1), 2048 + ch, 64)) = o1;
        }
    }
    const int xcd = vcu >> 5, cu = vcu & 31, slot = wave * 32 + cu;
    if (G != 256 || slot >= 144) return;
    const int bh = xcd * 4 + slot / 36, rem = slot % 36, ib = rem / 9, jv = rem % 9;
    const int b = bh >> 3, hh = bh & 7, r = lane & 31, h = lane >> 5;
    const bf16_t* KT = (const bf16_t*)(ws + WS_KT); const bf16_t* VT = (const bf16_t*)(ws + WS_VT);
    bf16_t* CT = (bf16_t*)(ws + WS_CT);
    float* misc = (float*)(ws + WS_MISC);
    const float* AAp = misc + MI_AA + (size_t)bh * SEQ + lane;
    float* NJ = misc + MI_NJ + (size_t)bh * 64 * 128;
    const bf16_t* ktp = KT + ((size_t)bh * 64 * 16 + ib * 4) * 512 + lane * 8;
    const bf16_t* vtp = VT + ((size_t)bh * 64 * 32 + (jv & 7) * 4) * 512 + lane * 8;
    LAS float* wsl = (LAS float*)(lds + wave * 256);
    float msv, m63v;
    {
        const float amx = misc[MI_AMX + bh * 64 + lane], gs = misc[MI_GS + bh * 64 + lane];
        float Gc = gs, Cc = gs + amx;
#pragma unroll
        for (int o = 1; o < 64; o <<= 1) { const float Gp = __shfl_up(Gc, o), Cp = __shfl_up(Cc, o); if (lane >= o) { Cc = fmaxf(Cp + Gc, Cc); Gc = Gp + Gc; } }
        const float mnext = fmaxf(Gc, Cc);
        msv = __shfl_up(mnext, 1); if (lane == 0) msv = 0.f;
        m63v = fmaxf(msv, amx);
        if (rem == 8) misc[MI_MS + bh * 64 + lane] = msv;
    }
    f32x16 acc;
#pragma unroll
    for (int i = 0; i < 16; ++i) acc[i] = 0.f;
    const u32x4 ones = (u32x4){ONES16, ONES16, ONES16, ONES16};
    struct OpSet { bf16x8 A[4]; u32x4 B[4]; float a; };
    auto load_set = [&](OpSet& S, int jj) {
        const int jc = jj < NCH ? jj : NCH - 1;
        S.a = AAp[64 * jc];
#pragma unroll
        for (int ks = 0; ks < 4; ++ks) { S.A[ks] = *(const bf16x8*)(ktp + (size_t)jc * 16 * 512 + 512 * ks); S.B[ks] = *(const u32x4*)(vtp + (size_t)jc * 32 * 512 + 512 * ks); }
    };
    auto step = [&](int j, const OpSet& S) {
        const float ms_j = __int_as_float(__builtin_amdgcn_readlane(__float_as_int(msv), j)), m63 = __int_as_float(__builtin_amdgcn_readlane(__float_as_int(m63v), j));
        const float wgt = __expf(S.a - m63), keep = __expf(ms_j - m63);
        wsl[lane] = wgt;
        if (jv < 8) {
            bf16_t* cp = CT + ((((size_t)(bh * 64 + j) * 8 + jv) * 8 + 2 * ib) * 64 + r) * 8 + 4 * h;
#pragma unroll
            for (int q = 0; q < 4; ++q) { u32x2 w; w.x = pk_bf16(acc[4 * q], acc[4 * q + 1]); w.y = pk_bf16(acc[4 * q + 2], acc[4 * q + 3]); *(u32x2*)(cp + ((q >> 1) * 64 + (q & 1) * 32) * 8) = w; }
        } else if (r == 0) {
            float* np = NJ + (size_t)j * 128 + 32 * ib + 4 * h;
#pragma unroll
            for (int q = 0; q < 4; ++q) *(f32x4*)(np + 8 * q) = (f32x4){acc[4 * q], acc[4 * q + 1], acc[4 * q + 2], acc[4 * q + 3]};
        }
        acc = acc * keep;
#pragma unroll
        for (int ks = 0; ks < 4; ++ks) {
            const u32x4 raw = (jv < 8) ? S.B[ks] : ones;
            const f32x4 wa = *(const LAS f32x4*)(wsl + 16 * ks + 4 * h), wb = *(const LAS f32x4*)(wsl + 16 * ks + 8 + 4 * h);
            u32x4 o;
            o.x = pk_bf16(bf_lo(raw.x) * wa[0], bf_hi(raw.x) * wa[1]); o.y = pk_bf16(bf_lo(raw.y) * wa[2], bf_hi(raw.y) * wa[3]);
            o.z = pk_bf16(bf_lo(raw.z) * wb[0], bf_hi(raw.z) * wb[1]); o.w = pk_bf16(bf_lo(raw.w) * wb[2], bf_hi(raw.w) * wb[3]);
            acc = mfma32(S.A[ks], __builtin_bit_cast(bf16x8, o), acc);
        }
    };
    OpSet S0, S1, S2, S3;
    load_set(S0, 0); load_set(S1, 1); load_set(S2, 2);
    for (int j = 0; j < NCH; j += 4) {
        load_set(S3, j + 3); step(j, S0);
        load_set(S0, j + 4); step(j + 1, S1);
        load_set(S1, j + 5); step(j + 2, S2);
        load_set(S2, j + 6); step(j + 3, S3);
    }
}

struct P4Pre { float cml, bbl, mst; bf16x8 qf[8]; bf16x8 cf[2][8]; };
template <int LB>
__device__ __forceinline__ void p4_pre_load(P4Pre& S, const bf16_t* Q, const bf16_t* CT, const float* misc, int u, int dvg, int lane) {
    const int l = 32 * LB + (lane & 31), bh_ = u >> 6, j_ = u & 63, t0_ = 64 * j_;
    S.cml = misc[MI_CM + (size_t)bh_ * SEQ + t0_ + l]; S.bbl = misc[MI_BB + (size_t)bh_ * SEQ + t0_ + l]; S.mst = misc[MI_MS + bh_ * 64 + j_];
#pragma unroll
    for (int ks = 0; ks < 8; ++ks) S.qf[ks] = *(const bf16x8*)(Q + ((size_t)(u * 2 + LB) * 8 + ks) * 512 + lane * 8);
#pragma unroll
    for (int ks = 0; ks < 8; ++ks) { S.cf[0][ks] = *(const bf16x8*)(CT + (((size_t)u * 8 + 2 * dvg) * 8 + ks) * 512 + lane * 8); S.cf[1][ks] = *(const bf16x8*)(CT + (((size_t)u * 8 + 2 * dvg + 1) * 8 + ks) * 512 + lane * 8); }
}
template <int LB>
__device__ __forceinline__ void p4_unit(const bf16_t* Q, const bf16_t* Kr, const bf16_t* VT, const bf16_t* CT, const bf16_t* OG, const bf16_t* ZA, bf16_t* HA,
                                        const float* misc, const float* hnw, LAS float* ssq, int unit, int par, int dvg, int lane, const P4Pre& cur, P4Pre& nxt, int next_unit) {
    asm volatile("" : "+v"(lane));
    const int r = lane & 31, h = lane >> 5, l = 32 * LB + r;
    const int bh = unit >> 6, j = unit & 63, b = bh >> 3, hh = bh & 7, t0 = 64 * j;
    const float cml = cur.cml, bbl = cur.bbl, mst = cur.mst;
    const float* AAp = misc + MI_AA + (size_t)bh * SEQ + t0 + 4 * h;
    const float* njp = misc + MI_NJ + ((size_t)bh * 64 + j) * 128 + 8 * h;
    bf16x8 kf[LB + 1][8];
#pragma unroll
    for (int sb = 0; sb <= LB; ++sb) {
#pragma unroll
        for (int ks = 0; ks < 8; ++ks) kf[sb][ks] = *(const bf16x8*)(Kr + ((size_t)(unit * 2 + sb) * 8 + ks) * 512 + lane * 8);
    }
    asm volatile("" ::: "memory");
    const float Ml = fmaxf(mst, cml), el = -bbl - Ml, winter = __expf(mst - Ml);
    f32x16 o0, o1;
#pragma unroll
    for (int i = 0; i < 16; ++i) { o0[i] = 0.f; o1[i] = 0.f; }
    float deni = 0.f;
#pragma unroll
    for (int ks = 0; ks < 8; ++ks) {
        const u32x4 qr = __builtin_bit_cast(u32x4, cur.qf[ks]);
        const f32x4 n0 = *(const f32x4*)(njp + 16 * ks), n1 = *(const f32x4*)(njp + 16 * ks + 4);
        deni += (bf_lo(qr.x) * n0[0] + bf_hi(qr.x) * n0[1]) + (bf_lo(qr.y) * n0[2] + bf_hi(qr.y) * n0[3]) + (bf_lo(qr.z) * n1[0] + bf_hi(qr.z) * n1[1]) + (bf_lo(qr.w) * n1[2] + bf_hi(qr.w) * n1[3]);
        o0 = mfma32(cur.cf[0][ks], cur.qf[ks], o0);
        o1 = mfma32(cur.cf[1][ks], cur.qf[ks], o1);
    }
    u32x4 va[LB + 1][2][2];
#pragma unroll
    for (int sb = 0; sb <= LB; ++sb)
#pragma unroll
        for (int sp = 0; sp < 2; ++sp)
#pragma unroll
            for (int db = 0; db < 2; ++db) va[sb][sp][db] = *(const u32x4*)(VT + (((size_t)unit * 8 + 2 * dvg + db) * 4 + 2 * sb + sp) * 512 + lane * 8);
    f32x4 a4[LB + 1][4];
#pragma unroll
    for (int sb = 0; sb <= LB; ++sb)
#pragma unroll
        for (int q = 0; q < 4; ++q) a4[sb][q] = *(const f32x4*)(AAp + 32 * sb + 8 * q);
    asm volatile("" ::: "memory");
    o0 = o0 * winter; o1 = o1 * winter; deni *= winter;
    f32x16 s[LB + 1];
#pragma unroll
    for (int sb = 0; sb <= LB; ++sb) {
#pragma unroll
        for (int i = 0; i < 16; ++i) s[sb][i] = 0.f;
#pragma unroll
        for (int ks = 0; ks < 8; ++ks) s[sb] = mfma32(kf[sb][ks], cur.qf[ks], s[sb]);
    }
    const size_t gzo = (((size_t)(unit * 2 + LB) * 32 + 8 * dvg) * 64 + lane) * 4;
    u32x2 og[2][4], za[2][4];
#pragma unroll
    for (int db = 0; db < 2; ++db)
#pragma unroll
        for (int q = 0; q < 4; ++q) { og[db][q] = *(const u32x2*)(OG + gzo + (4 * db + q) * 256); za[db][q] = *(const u32x2*)(ZA + gzo + (4 * db + q) * 256); }
    asm volatile("" ::: "memory");
    float den = 0.f;
#pragma unroll
    for (int sb = 0; sb <= LB; ++sb) {
        float pv[16];
#pragma unroll
        for (int q = 0; q < 4; ++q)
#pragma unroll
            for (int e = 0; e < 4; ++e) {
                const int srow = 32 * sb + 8 * q + 4 * h + e;
                const float d = (sb < LB || srow <= l) ? __expf(a4[sb][q][e] - Ml) : 0.f;
                const float p = s[sb][4 * q + e] * d; pv[4 * q + e] = p; den += p;
            }
#pragma unroll
        for (int sp = 0; sp < 2; ++sp) {
            u32x4 pb; pb.x = pk_bf16(pv[8 * sp], pv[8 * sp + 1]); pb.y = pk_bf16(pv[8 * sp + 2], pv[8 * sp + 3]); pb.z = pk_bf16(pv[8 * sp + 4], pv[8 * sp + 5]); pb.w = pk_bf16(pv[8 * sp + 6], pv[8 * sp + 7]);
            const bf16x8 bfr = __builtin_bit_cast(bf16x8, pb);
            o0 = mfma32(__builtin_bit_cast(bf16x8, va[sb][sp][0]), bfr, o0);
            o1 = mfma32(__builtin_bit_cast(bf16x8, va[sb][sp][1]), bfr, o1);
        }
    }
    float dtot = den + deni; dtot += __shfl_xor(dtot, 32);
    const float inv = 1.f / fmaxf(fabsf(dtot), __expf(el));
    float hg[32]; float ss = 0.f;
#pragma unroll
    for (int q = 0; q < 4; ++q) {
        hg[4 * q + 0] = o0[4 * q + 0] * inv * bf_lo(og[0][q].x); hg[4 * q + 1] = o0[4 * q + 1] * inv * bf_hi(og[0][q].x); hg[4 * q + 2] = o0[4 * q + 2] * inv * bf_lo(og[0][q].y); hg[4 * q + 3] = o0[4 * q + 3] * inv * bf_hi(og[0][q].y);
        hg[16 + 4 * q + 0] = o1[4 * q + 0] * inv * bf_lo(og[1][q].x); hg[16 + 4 * q + 1] = o1[4 * q + 1] * inv * bf_hi(og[1][q].x); hg[16 + 4 * q + 2] = o1[4 * q + 2] * inv * bf_lo(og[1][q].y); hg[16 + 4 * q + 3] = o1[4 * q + 3] * inv * bf_hi(og[1][q].y);
    }
#pragma unroll
    for (int i = 0; i < 32; ++i) ss += hg[i] * hg[i];
    ss += __shfl_xor(ss, 32);
    if (h == 0) ssq[(par * 4 + dvg) * 64 + l] = ss;
    p4_pre_load<LB>(nxt, Q, CT, misc, next_unit, dvg, lane);
    asm volatile("" ::: "memory");
    const float* hwp = hnw + hh * 256 + 64 * dvg + 4 * h;
    f32x4 hwv[2][4];
#pragma unroll
    for (int db = 0; db < 2; ++db)
#pragma unroll
        for (int q = 0; q < 4; ++q) hwv[db][q] = *(const f32x4*)(hwp + 32 * db + 8 * q);
    __syncthreads();
    const float tot = (ssq[(par * 4 + 0) * 64 + l] + ssq[(par * 4 + 1) * 64 + l]) + (ssq[(par * 4 + 2) * 64 + l] + ssq[(par * 4 + 3) * 64 + l]);
    const float rstd = rsqrtf(tot * (1.f / DV) + EPS);
    LAS unsigned char* patch = (LAS unsigned char*)ssq + 4096 + (dvg * 2 + LB) * 4608;
#pragma unroll
    for (int q = 0; q < 4; ++q) {
#pragma unroll
        for (int db = 0; db < 2; ++db) {
            const u32x2 z = za[db][q]; const f32x4 hw = hwv[db][q];
            const float v0 = hg[16 * db + 4 * q + 0] * rstd * hw[0] * bf_lo(z.x), v1 = hg[16 * db + 4 * q + 1] * rstd * hw[1] * bf_hi(z.x);
            const float v2 = hg[16 * db + 4 * q + 2] * rstd * hw[2] * bf_lo(z.y), v3 = hg[16 * db + 4 * q + 3] * rstd * hw[3] * bf_hi(z.y);
            u32x2 w; w.x = pk_bf16(v0, v1); w.y = pk_bf16(v2, v3);
            *(LAS u32x2*)(patch + r * 144 + (32 * db + 8 * q + 4 * h) * 2) = w;
        }
    }
    asm volatile("s_waitcnt lgkmcnt(0)" ::: "memory");
    bf16_t* hap = HA + pg8::ktm((size_t)b * SEQ + t0 + 32 * LB, hh * 256 + 64 * dvg, 64) + lane * 8;
#pragma unroll
    for (int i = 0; i < 4; ++i) {
        const u32x4 w = *(const LAS u32x4*)(patch + (8 * i + (lane >> 3)) * 144 + (lane & 7) * 16);
        *(u32x4*)(hap + i * 512) = w;
    }
}

__device__ __forceinline__ void p4_mlstm_out(const Args& a, LAS unsigned char* lds, int tid, int lane, int wave, int vcu, int G) {
    unsigned char* ws = a.ws;
    const bf16_t* Q = (const bf16_t*)(ws + WS_Q); const bf16_t* Kr = (const bf16_t*)(ws + WS_K); const bf16_t* VT = (const bf16_t*)(ws + WS_VT);
    const bf16_t* CT = (const bf16_t*)(ws + WS_CT); const bf16_t* OG = (const bf16_t*)(ws + WS_OG); const bf16_t* ZA = (const bf16_t*)(ws + WS_ZA);
    bf16_t* HA = (bf16_t*)(ws + WS_HAB);
    const float* misc = (const float*)(ws + WS_MISC); const float* hnw = a.in[8];
    LAS float* ssq = (LAS float*)lds;
    const int lb = wave & 1, dvg = wave >> 1;
    constexpr int NU = 32 * NCH;
    if (vcu >= NU) return;
    auto run = [&](auto LBC) {
        constexpr int LB = decltype(LBC)::value;
        P4Pre A, B;
        p4_pre_load<LB>(A, Q, CT, misc, vcu, dvg, lane);
#pragma unroll 1
        for (int unit = vcu; unit < NU; unit += 2 * G) {
            const int u1 = unit + G, u2 = unit + 2 * G;
            p4_unit<LB>(Q, Kr, VT, CT, OG, ZA, HA, misc, hnw, ssq, unit, 0, dvg, lane, A, B, u1 < NU ? u1 : unit);
            if (u1 >= NU) break;
            p4_unit<LB>(Q, Kr, VT, CT, OG, ZA, HA, misc, hnw, ssq, u1, 1, dvg, lane, B, A, u2 < NU ? u2 : u1);
        }
    };
    if (lb == 0) run(std::integral_constant<int, 0>{}); else run(std::integral_constant<int, 1>{});
}

constexpr int N_PHASES = 7;
__global__ void __launch_bounds__(NWAVES * 64, 2) fwd_kernel(Args args) {
    extern __shared__ __attribute__((aligned(16))) unsigned char lds_raw[];
    LAS unsigned char* lds = (LAS unsigned char*)lds_raw;
    const int tid = threadIdx.x, lane = tid & 63, wave = __builtin_amdgcn_readfirstlane(tid >> 6);
    const int G = gridDim.x; const int bx = blockIdx.x; const int vcu = (G % 8 == 0) ? (bx % 8) * (G / 8) + bx / 8 : bx;
    unsigned char* ws = args.ws;
    volatile LAS unsigned* bst = (volatile LAS unsigned*)(lds + LDS_BYTES - 64);
    if (tid < 16) bst[tid] = 0u;
    __syncthreads();
    XcdBarrier bar; bar.bar = (unsigned*)(ws + WS_CTL) + CW_BAR + args.li * XCD_BAR_WORDS; bar.x = 0; bar.st = nullptr;
    const int lo = args.ph_lo, hi = args.ph_hi;
    if (hi - lo > 1) bar = xcd_barrier_post((unsigned*)(ws + WS_CTL) + CW_BAR + args.li * XCD_BAR_WORDS, bst);
#ifndef PH_MASK
#define PH_MASK 0x7f
#endif
#define IN(k) (((PH_MASK >> (k)) & 1) && lo <= (k) && (k) < hi)
#define SEAM(k) do { if (IN(k) && IN((k) + 1)) xcd_barrier(bar); } while (0)
    if (IN(0)) { p0_prep(args, lds, tid, lane, wave, vcu, G); } SEAM(0);
    if (IN(1)) { p1_hnorm(args, lds, tid, lane, wave, G); } SEAM(1);
    if (IN(2)) {
        pg8::Gemm g{(const bf16_t*)(ws + WS_H), (const bf16_t*)(ws + WS_WINT), MTOK, NPRJ, DM, DM, 64, 0, 0, 128, 256 * DM * 2, 0, 32768, 32 * 32768};
        pg8::StaticOrder S; S.init(MTOK, NPRJ, G, bx);
        pg8::EpiInProj E{(bf16_t*)(ws + WS_Q), (bf16_t*)(ws + WS_K), (bf16_t*)(ws + WS_KT), (bf16_t*)(ws + WS_VT), (bf16_t*)(ws + WS_OG), (bf16_t*)(ws + WS_ZA),
                         (bf16_t*)(ws + WS_HAB), (bf16_t*)args.out, (bf16_t*)args.out + (size_t)MTOK * DM,
                         (const float*)(ws + WS_MISC) + MI_BPERM, args.in[7], (float*)(ws + WS_SB), 4096, lds + 131072};
        pg8::gemm_phase<pg8::EpiInProj, true, true>(lds, g, S, E);
    } SEAM(2);
    if (IN(3)) { p3_scan(args, lds, tid, lane, wave, vcu, G); } SEAM(3);
    if (IN(4)) { p4_mlstm_out(args, lds, tid, lane, wave, vcu, G); } SEAM(4);
    if (IN(5)) {
        pg8::Gemm g{(const bf16_t*)(ws + WS_HAB), (const bf16_t*)(ws + WS_WAB), MTOK, DM, DM, 64, 64, 32 * 32768, 0, 32768, 64 * 32768, 32 * 32768, 32768, 64 * 32768};
        pg8::MergeOrder S; S.so.init(MTOK, DM, G, bx);
        pg8::EpiMerge E{(const bf16_t*)args.out, (const bf16_t*)args.out + (size_t)MTOK * DM, (bf16_t*)(ws + WS_MG)};
        pg8::gemm_phase<pg8::EpiMerge, true, true, pg8::MergeOrder>(lds, g, S, E);
    } SEAM(5);
    if (IN(6)) {
        pg8::Gemm g{(const bf16_t*)(ws + WS_MG), (const bf16_t*)(ws + WS_WOS), MTOK, DM, DM, 64, 64, 0, DM * DM * 2, 32768, 32 * 32768, 0, 32768, 32 * 32768};
        pg8::PanelOrder S{vcu};
        pg8::EpiOutNorm E{args.in[0], (const float*)(ws + WS_CTL) + CW_MOD + 4096, args.in[12], args.out, (float*)(ws + WS_CTL) + CW_ROWSS, (unsigned*)(ws + WS_CTL) + CW_CNT};
        pg8::gemm_phase<pg8::EpiOutNorm, true, true, pg8::PanelOrder>(lds, g, S, E);
    }
#undef IN
#undef SEAM
}

extern "C" void kernel_launch(void* const* d_in, const int* in_sizes, int n_in, void* d_out, int out_size, void* d_ws, size_t ws_size, hipStream_t stream) {
    static int grid = 0;
    if (grid == 0) {
        if (n_in != 13 || out_size != MTOK * DM || ws_size < WS_END) { fprintf(stderr, "kernel_launch: unexpected problem (n_in %d, out %d, ws %zu)\n", n_in, out_size, ws_size); grid = -1; return; }
        int dev = 0, cus = 0, per_cu = 0;
        if (hipGetDevice(&dev) != hipSuccess || hipDeviceGetAttribute(&cus, hipDeviceAttributeMultiprocessorCount, dev) != hipSuccess) { grid = -1; return; }
        if (hipFuncSetAttribute((const void*)fwd_kernel, hipFuncAttributeMaxDynamicSharedMemorySize, LDS_BYTES) != hipSuccess) { fprintf(stderr, "kernel_launch: hipFuncSetAttribute failed\n"); grid = -1; return; }
        if (hipOccupancyMaxActiveBlocksPerMultiprocessor(&per_cu, (const void*)fwd_kernel, NWAVES * 64, LDS_BYTES) != hipSuccess || per_cu < 1) { fprintf(stderr, "kernel_launch: occupancy query says %d blocks per CU\n", per_cu); }
        (void)hipGetLastError();
        grid = cus;
        if (grid != 256) fprintf(stderr, "kernel_launch: %d CUs; the phase program is laid out for 256\n", grid);
    }
    if (grid < 0) return;
    (void)hipMemsetAsync((char*)d_ws + WS_CTL, 0, CTL_ZERO_BYTES, stream);
    Args a{};
    for (int i = 0; i < 13; ++i) a.in[i] = (const float*)d_in[i];
    a.out = (float*)d_out; a.ws = (unsigned char*)d_ws;
#ifdef PROF_SEQ
    if (true) {
        const int seq[][2] = PROF_SEQ;
        for (unsigned i = 0; i < sizeof(seq) / sizeof(seq[0]); ++i) { a.ph_lo = seq[i][0]; a.ph_hi = seq[i][1]; a.li = i; hipLaunchKernelGGL(fwd_kernel, dim3(grid), dim3(NWAVES * 64), LDS_BYTES, stream, a); }
    } else
#endif
    if (MK_N_LAUNCHES == 1) {
        a.ph_lo = 0; a.ph_hi = N_PHASES; a.li = 0;
        hipLaunchKernelGGL(fwd_kernel, dim3(grid), dim3(NWAVES * 64), LDS_BYTES, stream, a);
    } else {
        for (int p = 0; p < N_PHASES; ++p) { a.ph_lo = p; a.ph_hi = p + 1; a.li = p; hipLaunchKernelGGL(fwd_kernel, dim3(grid), dim3(NWAVES * 64), LDS_BYTES, stream, a); }
    }
}
```
